# Optimizing an MI355X kernel written in HIP

```python
import math
import jax, jax.numpy as jnp
from jax import lax
import numpy as np

D_MODEL = 1024
BATCH = 8
SEQ = 2048
DEPTH = 2

GRID_W = 64
CTX_LEN = 256
ROPE_BASE = 10000.0
EPS = 1e-6

MLA_HEADS = 4
MLA_NOPE = 128
MLA_ROPE = 64
MLA_V = 128
MLA_QK = MLA_NOPE + MLA_ROPE
MLA_Q_RANK = 384
MLA_KV_RANK = 256
Q_BLOCK = 128
CONV_CH = 256
CONV_WIDTH = 31
SWA_HEADS = 4
SWA_KV_HEADS = 2
SWA_HEAD_DIM = 64
SWA_WINDOW = 128
SWA_BLOCK = 128
N_EXPERTS = 32
TOP_K = 4
D_EXPERT = D_MODEL
SWIGLU_LIMIT = 7.0
SWIGLU_ALPHA = 1.702
EXPERT_BLOCK = 256

O_CKV = 0
O_KROPE = O_CKV + MLA_KV_RANK
O_SK = O_KROPE + MLA_ROPE
O_SV = O_SK + SWA_KV_HEADS * SWA_HEAD_DIM
O_CQ = O_SV + SWA_KV_HEADS * SWA_HEAD_DIM
KV_COLS = O_CQ
O_SQ = O_CQ + MLA_Q_RANK
O_GLU = O_SQ + SWA_HEADS * SWA_HEAD_DIM
IN_COLS = O_GLU + 2 * CONV_CH
MIX_WIDTH = MLA_HEADS * MLA_V + CONV_CH + SWA_HEADS * SWA_HEAD_DIM

kernel_name = 'hybrid_mla_conformer_swa_moe_dit'


def rms_norm(x, g):
    xf = x.astype(jnp.float32)
    y = xf * lax.rsqrt(jnp.mean(xf * xf, axis=-1, keepdims=True) + EPS)
    return (y * g.astype(jnp.float32)).astype(x.dtype)


def layer_norm(x, g, b):
    xf = x.astype(jnp.float32)
    mu = jnp.mean(xf, axis=-1, keepdims=True)
    var = jnp.mean(jnp.square(xf - mu), axis=-1, keepdims=True)
    y = (xf - mu) * lax.rsqrt(var + EPS) * g.astype(jnp.float32) + b.astype(jnp.float32)
    return y.astype(x.dtype)


def modulate(h, shift, scale):
    return h * (1 + scale) + shift


def axial_rope_tables(n_rows, rot_dim):
    q = rot_dim // 4
    row = jnp.repeat(jnp.arange(n_rows, dtype=jnp.float32), GRID_W)
    col = jnp.tile(jnp.arange(GRID_W, dtype=jnp.float32), n_rows)
    inv = ROPE_BASE ** (-jnp.arange(q, dtype=jnp.float32) / q)
    ang = jnp.stack([row[:, None] * inv, col[:, None] * inv], axis=1)
    return jnp.cos(ang), jnp.sin(ang)


def apply_rope(x, cos, sin):
    q = x.shape[-1] // 4
    xr = x.astype(jnp.float32).reshape(x.shape[:-1] + (2, 2, q))
    x1, x2 = xr[..., 0, :], xr[..., 1, :]
    cs, sn = cos[:, None], sin[:, None]
    out = jnp.stack([x1 * cs - x2 * sn, x1 * sn + x2 * cs], axis=-2)
    return out.reshape(x.shape).astype(x.dtype)


def mla_keys(ckv, krope, kv_norm_g, w_ukv, k_head_g, rope):
    bsz, n, _ = ckv.shape
    kv = (rms_norm(ckv, kv_norm_g) @ w_ukv).reshape(bsz, n, MLA_HEADS, MLA_NOPE + MLA_V)
    k_nope, v = kv[..., :MLA_NOPE], kv[..., MLA_NOPE:]
    k_pe = jnp.broadcast_to(krope[:, :, None, :], (bsz, n, MLA_HEADS, MLA_ROPE))
    k = rms_norm(jnp.concatenate([k_nope, k_pe], axis=-1), k_head_g)
    if rope is not None:
        k = jnp.concatenate([k[..., :MLA_NOPE], apply_rope(k[..., MLA_NOPE:], *rope)], axis=-1)
    return k, v


def mla_queries(cq, q_norm_g, w_uq, q_head_g, rope):
    bsz, n, _ = cq.shape
    q = (rms_norm(cq, q_norm_g) @ w_uq).reshape(bsz, n, MLA_HEADS, MLA_QK)
    q = rms_norm(q, q_head_g)
    if rope is not None:
        q = jnp.concatenate([q[..., :MLA_NOPE], apply_rope(q[..., MLA_NOPE:], *rope)], axis=-1)
    return q


def mla_latent_attention(q, k_lat, v_lat, k_ctx, v_ctx):
    bsz, n, nh, dq = q.shape
    k = jnp.concatenate([k_ctx, k_lat], axis=1)
    v = jnp.concatenate([v_ctx, v_lat], axis=1)
    nb = n // Q_BLOCK
    qb = q.reshape(bsz, nb, Q_BLOCK, nh, dq).transpose(1, 0, 2, 3, 4)
    scale = MLA_QK ** -0.5

    def block(qi):
        s = jnp.einsum('bqhd,bkhd->bhqk', qi, k, preferred_element_type=jnp.float32) * scale
        p = jax.nn.softmax(s, axis=-1).astype(v.dtype)
        return jnp.einsum('bhqk,bkhd->bqhd', p, v)

    out = lax.map(block, qb)
    return out.transpose(1, 0, 2, 3, 4).reshape(bsz, n, nh * MLA_V)


def mla_ctx_attention(q, k, v):
    bsz, n, nh, _ = q.shape
    s = jnp.einsum('bqhd,bkhd->bhqk', q, k, preferred_element_type=jnp.float32) * (MLA_QK ** -0.5)
    p = jax.nn.softmax(s, axis=-1).astype(v.dtype)
    return jnp.einsum('bhqk,bkhd->bqhd', p, v).reshape(bsz, n, nh * MLA_V)


def swa_keys(sk, sv, k_g, rope):
    bsz, n, _ = sk.shape
    k = rms_norm(sk.reshape(bsz, n, SWA_KV_HEADS, SWA_HEAD_DIM), k_g)
    if rope is not None:
        k = apply_rope(k, *rope)
    return k, sv.reshape(bsz, n, SWA_KV_HEADS, SWA_HEAD_DIM)


def swa_queries(sq, q_g, rope):
    bsz, n, _ = sq.shape
    q = rms_norm(sq.reshape(bsz, n, SWA_HEADS, SWA_HEAD_DIM), q_g)
    if rope is not None:
        q = apply_rope(q, *rope)
    return q


def swa_latent_attention(q, k, v, k_ctx, v_ctx, sink):
    bsz, n, _, dh = q.shape
    grp = SWA_HEADS // SWA_KV_HEADS
    nb = n // SWA_BLOCK
    span = SWA_BLOCK + 2 * SWA_WINDOW
    pad = ((0, 0), (SWA_WINDOW, SWA_WINDOW), (0, 0), (0, 0))
    kp, vp = jnp.pad(k, pad), jnp.pad(v, pad)
    idx = jnp.arange(nb)[:, None] * SWA_BLOCK + jnp.arange(span)[None, :]
    kb, vb = kp[:, idx], vp[:, idx]
    qb = q.reshape(bsz, nb, SWA_BLOCK, SWA_KV_HEADS, grp, dh)
    scale = dh ** -0.5
    s_loc = jnp.einsum('bnqhgd,bnkhd->bnhgqk', qb, kb, preferred_element_type=jnp.float32) * scale
    qpos = jnp.arange(nb)[:, None] * SWA_BLOCK + jnp.arange(SWA_BLOCK)[None, :]
    kpos = idx - SWA_WINDOW
    rel = kpos[:, None, :] - qpos[:, :, None]
    valid = (jnp.abs(rel) <= SWA_WINDOW) & (kpos[:, None, :] >= 0) & (kpos[:, None, :] < n)
    s_loc = jnp.where(valid[None, :, None, None], s_loc, -jnp.inf)
    s_ctx = jnp.einsum('bnqhgd,bchd->bnhgqc', qb, k_ctx, preferred_element_type=jnp.float32) * scale
    s_sink = jnp.broadcast_to(sink.astype(jnp.float32).reshape(SWA_KV_HEADS, grp)[None, None, :, :, None, None], s_loc.shape[:-1] + (1,))
    p = jax.nn.softmax(jnp.concatenate([s_loc, s_ctx, s_sink], axis=-1), axis=-1).astype(v.dtype)
    n_c = k_ctx.shape[1]
    out = jnp.einsum('bnhgqk,bnkhd->bnqhgd', p[..., :span], vb) + jnp.einsum('bnhgqc,bchd->bnqhgd', p[..., span:span + n_c], v_ctx)
    return out.reshape(bsz, n, SWA_HEADS * dh)


def swa_ctx_attention(q, k, v, sink):
    bsz, n, _, dh = q.shape
    grp = SWA_HEADS // SWA_KV_HEADS
    qg = q.reshape(bsz, n, SWA_KV_HEADS, grp, dh)
    s = jnp.einsum('bqhgd,bkhd->bhgqk', qg, k, preferred_element_type=jnp.float32) * (dh ** -0.5)
    s_sink = jnp.broadcast_to(sink.astype(jnp.float32).reshape(SWA_KV_HEADS, grp)[None, :, :, None, None], s.shape[:-1] + (1,))
    p = jax.nn.softmax(jnp.concatenate([s, s_sink], axis=-1), axis=-1)[..., :n].astype(v.dtype)
    return jnp.einsum('bhgqk,bkhd->bqhgd', p, v).reshape(bsz, n, SWA_HEADS * dh)


def conformer_conv(glu_in, w, b, ln_g, ln_b):
    a, gate = glu_in[..., :CONV_CH], glu_in[..., CONV_CH:]
    u = a * jax.nn.sigmoid(gate)
    y = lax.conv_general_dilated(u, w[:, None, :], window_strides=(1,), padding=[(CONV_WIDTH // 2, CONV_WIDTH // 2)], dimension_numbers=('NWC', 'WIO', 'NWC'), feature_group_count=CONV_CH) + b
    return jax.nn.silu(layer_norm(y, ln_g, ln_b))


def moe(h, w_r, b_r, w1, b1, w2, b2):
    n_tok, dm = h.shape
    logits = (h @ w_r + b_r).astype(jnp.float32)
    top_v, top_i = lax.top_k(logits, TOP_K)
    gates = jax.nn.softmax(top_v, axis=-1)
    nk = n_tok * TOP_K
    e_flat = top_i.reshape(-1)
    tok_flat = jnp.arange(nk, dtype=jnp.int32) // TOP_K
    g_flat = gates.reshape(-1)
    order = jnp.argsort(e_flat)
    se, st, sg = e_flat[order], tok_flat[order], g_flat[order]
    counts = jax.ops.segment_sum(jnp.ones_like(e_flat), e_flat, num_segments=N_EXPERTS)
    padded = (counts + EXPERT_BLOCK - 1) // EXPERT_BLOCK * EXPERT_BLOCK
    start = jnp.cumsum(counts) - counts
    pend = jnp.cumsum(padded)
    pstart = pend - padded
    dest = pstart[se] + jnp.arange(nk, dtype=jnp.int32) - start[se]
    n_buf = -(-nk // EXPERT_BLOCK) * EXPERT_BLOCK + N_EXPERTS * EXPERT_BLOCK
    nb = n_buf // EXPERT_BLOCK
    row_tok = jnp.full((n_buf,), n_tok, jnp.int32).at[dest].set(st)
    row_w = jnp.zeros((n_buf,), jnp.float32).at[dest].set(sg)
    block_e = jnp.minimum(jnp.searchsorted(pend, jnp.arange(nb, dtype=jnp.int32) * EXPERT_BLOCK, side='right'), N_EXPERTS - 1)
    h_pad = jnp.concatenate([h, jnp.zeros((1, dm), h.dtype)], axis=0)
    xb = h_pad[row_tok].reshape(nb, EXPERT_BLOCK, dm)

    def expert_block(args):
        xi, e = args
        u = xi @ w1[e] + b1[e]
        x_glu = jnp.minimum(u[..., ::2], SWIGLU_LIMIT)
        x_lin = jnp.clip(u[..., 1::2], -SWIGLU_LIMIT, SWIGLU_LIMIT)
        act = x_glu * jax.nn.sigmoid(SWIGLU_ALPHA * x_glu) * (x_lin + 1)
        return act @ w2[e] + b2[e]

    yb = lax.map(expert_block, (xb, block_e)).reshape(n_buf, dm)
    y = jax.ops.segment_sum(yb * row_w[:, None].astype(yb.dtype), row_tok, num_segments=n_tok + 1)
    return y[:n_tok]


def setup_inputs(seed: int = 0) -> dict:
    key = jax.random.key(seed)
    ks = jax.random.split(key, 32)
    f32 = jnp.float32
    L = DEPTH

    def nrm(k, shape, s):
        return jax.random.normal(k, shape, f32) * s

    def gain(k, shape):
        return 1.0 + 0.02 * jax.random.normal(k, shape, f32)

    return {
        'x': nrm(ks[0], (BATCH, SEQ, D_MODEL), 1.0),
        'c': nrm(ks[1], (BATCH, D_MODEL), 1.0),
        'ctx': nrm(ks[2], (BATCH, CTX_LEN, D_MODEL), 1.0),
        'c_ctx': nrm(ks[3], (D_MODEL,), 1.0),
        'norm1_g': gain(ks[4], (L, D_MODEL)),
        'norm2_g': gain(ks[5], (L, D_MODEL)),
        'w_ada': nrm(ks[6], (L, D_MODEL, 6 * D_MODEL), 0.5 * D_MODEL ** -0.5),
        'b_ada': nrm(ks[7], (L, 6 * D_MODEL), 0.02),
        'w_in': nrm(ks[8], (L, D_MODEL, IN_COLS), D_MODEL ** -0.5),
        'mla_q_norm': gain(ks[9], (L, MLA_Q_RANK)),
        'mla_kv_norm': gain(ks[10], (L, MLA_KV_RANK)),
        'mla_w_uq': nrm(ks[11], (L, MLA_Q_RANK, MLA_HEADS * MLA_QK), MLA_Q_RANK ** -0.5),
        'mla_w_ukv': nrm(ks[12], (L, MLA_KV_RANK, MLA_HEADS * (MLA_NOPE + MLA_V)), MLA_KV_RANK ** -0.5),
        'mla_q_head_norm': gain(ks[13], (L, MLA_QK)),
        'mla_k_head_norm': gain(ks[14], (L, MLA_QK)),
        'conv_w': nrm(ks[15], (L, CONV_WIDTH, CONV_CH), CONV_WIDTH ** -0.5),
        'conv_b': nrm(ks[16], (L, CONV_CH), 0.02),
        'conv_ln_g': gain(ks[17], (L, CONV_CH)),
        'conv_ln_b': nrm(ks[18], (L, CONV_CH), 0.02),
        'swa_q_norm': gain(ks[19], (L, SWA_HEAD_DIM)),
        'swa_k_norm': gain(ks[20], (L, SWA_HEAD_DIM)),
        'swa_sink': nrm(ks[21], (L, SWA_HEADS), 0.5),
        'w_out': nrm(ks[22], (L, MIX_WIDTH, D_MODEL), MIX_WIDTH ** -0.5),
        'router_w': nrm(ks[23], (L, D_MODEL, N_EXPERTS), D_MODEL ** -0.5),
        'router_b': nrm(ks[24], (L, N_EXPERTS), 0.01),
        'exp_w1': nrm(ks[25], (L, N_EXPERTS, D_MODEL, 2 * D_EXPERT), D_MODEL ** -0.5),
        'exp_b1': nrm(ks[26], (L, N_EXPERTS, 2 * D_EXPERT), 0.02),
        'exp_w2': nrm(ks[27], (L, N_EXPERTS, D_EXPERT, D_MODEL), D_EXPERT ** -0.5),
        'exp_b2': nrm(ks[28], (L, N_EXPERTS, D_MODEL), 0.02),
    }


def reference(x, c, ctx, c_ctx, norm1_g, norm2_g, w_ada, b_ada, w_in, mla_q_norm, mla_kv_norm, mla_w_uq, mla_w_ukv, mla_q_head_norm, mla_k_head_norm, conv_w, conv_b, conv_ln_g, conv_ln_b, swa_q_norm, swa_k_norm, swa_sink, w_out, router_w, router_b, exp_w1, exp_b1, exp_w2, exp_b2):
    bsz, n_lat, dm = x.shape
    n_ctx = ctx.shape[1]
    n_rows = n_lat // GRID_W
    rope_mla = axial_rope_tables(n_rows, MLA_ROPE)
    rope_swa = axial_rope_tables(n_rows, SWA_HEAD_DIM)
    s_lat = jax.nn.silu(c)
    s_ctx = jax.nn.silu(c_ctx)
    xc = ctx
    for l in range(DEPTH):
        last = l == DEPTH - 1
        m_lat = (s_lat @ w_ada[l] + b_ada[l])[:, None, :]
        m_ctx = s_ctx @ w_ada[l] + b_ada[l]
        sh1, sc1, g1, sh2, sc2, g2 = jnp.split(m_lat, 6, axis=-1)
        csh1, csc1, cg1, csh2, csc2, cg2 = jnp.split(m_ctx, 6, axis=-1)

        h = modulate(rms_norm(x, norm1_g[l]), sh1, sc1)
        hc = modulate(rms_norm(xc, norm1_g[l]), csh1, csc1)
        p = h @ w_in[l]
        pc = hc @ (w_in[l][:, :KV_COLS] if last else w_in[l])

        k_mla_c, v_mla_c = mla_keys(pc[..., O_CKV:O_KROPE], pc[..., O_KROPE:O_SK], mla_kv_norm[l], mla_w_ukv[l], mla_k_head_norm[l], None)
        k_swa_c, v_swa_c = swa_keys(pc[..., O_SK:O_SV], pc[..., O_SV:O_CQ], swa_k_norm[l], None)

        k_mla, v_mla = mla_keys(p[..., O_CKV:O_KROPE], p[..., O_KROPE:O_SK], mla_kv_norm[l], mla_w_ukv[l], mla_k_head_norm[l], rope_mla)
        q_mla = mla_queries(p[..., O_CQ:O_SQ], mla_q_norm[l], mla_w_uq[l], mla_q_head_norm[l], rope_mla)
        o_mla = mla_latent_attention(q_mla, k_mla, v_mla, k_mla_c, v_mla_c)
        o_conv = conformer_conv(p[..., O_GLU:], conv_w[l], conv_b[l], conv_ln_g[l], conv_ln_b[l])
        k_swa, v_swa = swa_keys(p[..., O_SK:O_SV], p[..., O_SV:O_CQ], swa_k_norm[l], rope_swa)
        q_swa = swa_queries(p[..., O_SQ:O_GLU], swa_q_norm[l], rope_swa)
        o_swa = swa_latent_attention(q_swa, k_swa, v_swa, k_swa_c, v_swa_c, swa_sink[l])
        mix = jnp.concatenate([o_mla, o_conv, o_swa], axis=-1) @ w_out[l]

        if not last:
            q_mla_c = mla_queries(pc[..., O_CQ:O_SQ], mla_q_norm[l], mla_w_uq[l], mla_q_head_norm[l], None)
            oc_mla = mla_ctx_attention(q_mla_c, k_mla_c, v_mla_c)
            oc_conv = conformer_conv(pc[..., O_GLU:], conv_w[l], conv_b[l], conv_ln_g[l], conv_ln_b[l])
            q_swa_c = swa_queries(pc[..., O_SQ:O_GLU], swa_q_norm[l], None)
            oc_swa = swa_ctx_attention(q_swa_c, k_swa_c, v_swa_c, swa_sink[l])
            xc = xc + cg1 * (jnp.concatenate([oc_mla, oc_conv, oc_swa], axis=-1) @ w_out[l])
        x = x + g1 * mix

        hf = modulate(rms_norm(x, norm2_g[l]), sh2, sc2)
        if last:
            y = moe(hf.reshape(-1, dm), router_w[l], router_b[l], exp_w1[l], exp_b1[l], exp_w2[l], exp_b2[l])
            x = x + g2 * y.reshape(bsz, n_lat, dm)
        else:
            hfc = modulate(rms_norm(xc, norm2_g[l]), csh2, csc2)
            tok = jnp.concatenate([hfc, hf], axis=1).reshape(-1, dm)
            y = moe(tok, router_w[l], router_b[l], exp_w1[l], exp_b1[l], exp_w2[l], exp_b2[l]).reshape(bsz, n_ctx + n_lat, dm)
            xc = xc + cg2 * y[:, :n_ctx]
            x = x + g2 * y[:, n_ctx:]
    return x
```

```cpp
#include <hip/hip_runtime.h>
#include <cstdio>
#include <cstdint>

#ifndef MK_N_LAUNCHES
#define MK_N_LAUNCHES 1
#endif

#define GAS __attribute__((address_space(1)))
#define LAS __attribute__((address_space(3)))
typedef unsigned short bf16;
typedef short bf16x8 __attribute__((ext_vector_type(8)));
typedef int i32x8 __attribute__((ext_vector_type(8)));
typedef int i32x4 __attribute__((ext_vector_type(4)));
typedef short s16x4 __attribute__((ext_vector_type(4)));
typedef float f32x4 __attribute__((ext_vector_type(4)));
typedef float f32x2 __attribute__((ext_vector_type(2)));
typedef float f32x16 __attribute__((ext_vector_type(16)));
typedef unsigned u32x4 __attribute__((ext_vector_type(4)));
typedef unsigned u32x2 __attribute__((ext_vector_type(2)));

constexpr int DM = 1024, NBATCH = 8, SEQ = 2048, NCTX = 256;
constexpr int TL = NBATCH * SEQ, TC = NBATCH * NCTX, NTOK = TL + TC, NKEY = NCTX + SEQ;
constexpr int INC = 1728, INP = 1792;
constexpr int O_KROPE = 256, O_SK = 320, O_CQ = 576, O_SQ = 960, O_GLU = 1216;
constexpr int NE = 32, NLAYER = 2;
constexpr float EPS = 1e-6f;
constexpr int NWAVES = 8, NTHREADS = 512;

constexpr size_t KiB = 1024, MiB = 1024 * 1024;
constexpr size_t WS_CTL = 0, CTL_BYTES = 1 * MiB;
constexpr int CW_BAR = 4096;
constexpr int CW_CNT = 8192;
constexpr size_t WS_ADA = 1 * MiB;
constexpr size_t WS_ROPE = 2 * MiB;
constexpr size_t WS_ROUTEG = 3 * MiB;
constexpr size_t WS_LISTE = 4 * MiB;
constexpr size_t WS_W = 8 * MiB;
constexpr size_t WB_IN = 0, WB_UKV = WB_IN + (size_t)INP * 1024 * 2, WB_UQ = WB_UKV + (size_t)1024 * 256 * 2, WB_OUT = WB_UQ + (size_t)768 * 384 * 2,
                 WB_W1 = WB_OUT + (size_t)1024 * 1024 * 2, WB_W2 = WB_W1 + (size_t)NE * 2048 * 1024 * 2, WB_LAYER = WB_W2 + (size_t)NE * 1024 * 1024 * 2;
static_assert(WB_LAYER % 256 == 0, "align");
constexpr size_t WS_XC = WS_W + 2 * WB_LAYER;
constexpr size_t WS_H = WS_XC + (size_t)TC * DM * 4;
constexpr size_t WS_P = WS_H + (size_t)NTOK * DM * 2;
constexpr size_t WS_CKVN = WS_P + (size_t)NTOK * INP * 2;
constexpr size_t WS_CQN = WS_CKVN + (size_t)NTOK * 256 * 2;
constexpr size_t WS_KRAW = WS_CQN + (size_t)NTOK * 384 * 2;
constexpr size_t WS_MQ = WS_KRAW;
constexpr size_t WS_QRAW = WS_KRAW + (size_t)NTOK * 512 * 2;
constexpr size_t WS_KMLA = WS_QRAW + (size_t)NTOK * 768 * 2;
constexpr size_t WS_VMLA = WS_KMLA + (size_t)32 * NKEY * 192 * 2;
constexpr size_t WS_QMLA = WS_VMLA + (size_t)32 * NKEY * 128 * 2;
constexpr size_t WS_SK = WS_QMLA + (size_t)32 * NKEY * 192 * 2;
constexpr size_t WS_SV = WS_SK + (size_t)16 * NKEY * 64 * 2;
constexpr size_t WS_SQ = WS_SV + (size_t)16 * NKEY * 64 * 2;
constexpr size_t WS_U = WS_SQ + (size_t)32 * NKEY * 64 * 2;
constexpr size_t WS_CAT = WS_U + (size_t)NTOK * 256 * 2;
constexpr size_t WS_ACT = WS_CAT + (size_t)NTOK * DM * 2;
constexpr int MAXBLK = 320;
constexpr size_t WS_YK = WS_ACT + (size_t)MAXBLK * 256 * 1024 * 2;
constexpr size_t WS_HF8 = WS_YK + (size_t)NTOK * 4 * 1024 * 2;
constexpr size_t WS_XS = WS_HF8 + (size_t)NTOK * 1024;
constexpr size_t WS_END = WS_XS + (size_t)NTOK * 1024 * 2;
static_assert(WS_XC % 256 == 0 && WS_P % 256 == 0 && WS_KMLA % 256 == 0 && WS_ACT % 256 == 0 && WS_YK % 256 == 0, "align");

constexpr int RING_BYTES = 131072;
constexpr int LDSCTL_OFF = RING_BYTES;
constexpr int MISC_OFF = LDSCTL_OFF;
constexpr int TAB_OFF = LDSCTL_OFF + 128;
constexpr int LDS_BYTES = 147456;

#define LDS_WAIT() asm volatile("s_waitcnt lgkmcnt(0)" ::: "memory")
#define VM_WAIT() asm volatile("s_waitcnt vmcnt(0)" ::: "memory")
__device__ __forceinline__ unsigned f2bf(float f) { unsigned u = __builtin_bit_cast(unsigned, f); return (u + 0x7fffu + ((u >> 16) & 1u)) >> 16; }
__device__ __forceinline__ unsigned pk2(float lo, float hi) { unsigned r; asm("v_cvt_pk_bf16_f32 %0, %1, %2" : "=v"(r) : "v"(lo), "v"(hi)); return r; }
__device__ __forceinline__ float bflo(unsigned w) { return __builtin_bit_cast(float, w << 16); }
__device__ __forceinline__ float bfhi(unsigned w) { return __builtin_bit_cast(float, w & 0xffff0000u); }
__device__ __forceinline__ unsigned cvt_pk_bf16(float lo, float hi) { unsigned r; asm volatile("v_cvt_pk_bf16_f32 %0, %1, %2" : "=v"(r) : "v"(lo), "v"(hi)); return r; }
template <int X> __device__ __forceinline__ float swz_xor(float v) { return __builtin_bit_cast(float, __builtin_amdgcn_ds_swizzle(__builtin_bit_cast(int, v), (X << 10) | 0x1f)); }
__device__ __forceinline__ float xhalf(float v) {
    unsigned a = __builtin_bit_cast(unsigned, v), b = a; asm volatile("" : "+v"(b));
    auto rr = __builtin_amdgcn_permlane32_swap(a, b, false, false);
    const unsigned own = __builtin_bit_cast(unsigned, v);
    return __builtin_bit_cast(float, rr[0] == own ? rr[1] : rr[0]);
}
template <int CTRL> __device__ __forceinline__ float dpp_mov(float v) { return __builtin_bit_cast(float, __builtin_amdgcn_update_dpp(0, __builtin_bit_cast(int, v), CTRL, 0xF, 0xF, false)); }
__device__ __forceinline__ float row16_sum(float v) { v += dpp_mov<0xB1>(v); v += dpp_mov<0x4E>(v); v += dpp_mov<0x124>(v); v += dpp_mov<0x128>(v); return v; }
__device__ __forceinline__ float row16_max(float v) { v = fmaxf(v, dpp_mov<0xB1>(v)); v = fmaxf(v, dpp_mov<0x4E>(v)); v = fmaxf(v, dpp_mov<0x124>(v)); v = fmaxf(v, dpp_mov<0x128>(v)); return v; }
__device__ __forceinline__ float rdl(float v, int l) { return __builtin_bit_cast(float, __builtin_amdgcn_readlane(__builtin_bit_cast(int, v), l)); }
__device__ __forceinline__ float wave_sum(float v) { v = row16_sum(v); return (rdl(v, 0) + rdl(v, 16)) + (rdl(v, 32) + rdl(v, 48)); }
__device__ __forceinline__ float grp16_sum(float v) { return row16_sum(v); }
__device__ __forceinline__ float wave_max(float v) { v = row16_max(v); return fmaxf(fmaxf(rdl(v, 0), rdl(v, 16)), fmaxf(rdl(v, 32), rdl(v, 48))); }
__device__ __forceinline__ int lane_id_now() { int l; asm volatile("v_mbcnt_lo_u32_b32 %0, -1, 0\n\tv_mbcnt_hi_u32_b32 %0, -1, %0" : "=v"(l)); return l; }
__device__ __forceinline__ float sigmoidf_(float x) { return __builtin_amdgcn_rcpf(1.f + __builtin_amdgcn_exp2f(x * -1.4426950408889634f)); }

#define XB_TMO      128
#define XB_XCNT(j)  (256  + 64 * (j))
#define XB_XSUB(j)  (1280 + 64 * (j))
#define XB_XGEN(j)  (2304 + 64 * (j))
#define XB_TOP      3328
#define XB_TOPGEN   3392
#define XCD_BAR_WORDS 3456
#define XB_SPIN_CAP (1u << 18)
__device__ __forceinline__ unsigned xb_ld(unsigned* p)              { return __hip_atomic_load(p, __ATOMIC_RELAXED, __HIP_MEMORY_SCOPE_AGENT); }
__device__ __forceinline__ unsigned xb_add(unsigned* p, unsigned v) { return __hip_atomic_fetch_add(p, v, __ATOMIC_RELAXED, __HIP_MEMORY_SCOPE_AGENT); }
__device__ __forceinline__ unsigned xb_xcc_id() { return (unsigned)__builtin_amdgcn_s_getreg((3 << 11) | 20) & 0xFu; }
#define XB_SPIN(cond, bar) do { unsigned _sp = 0; while (cond) { __builtin_amdgcn_s_sleep(1); \
    if ((++_sp & 255u) == 0u) { if (xb_ld(&(bar)[XB_TMO])) break; if (_sp > XB_SPIN_CAP) { atomicAdd(&(bar)[XB_TMO], 1u); break; } } } } while (0)
struct XcdBarrier { unsigned* bar; unsigned x; volatile LAS unsigned* st; };
__device__ __forceinline__ XcdBarrier xcd_barrier_post(unsigned* bar, volatile LAS unsigned* st, const int tid) {
    XcdBarrier b; b.bar = bar; b.x = xb_xcc_id(); b.st = st;
    if (tid == 0) (void)xb_add(&bar[XB_XCNT(b.x)], 1u);
    return b;
}
__device__ __forceinline__ void xcd_barrier_complete(unsigned* bar, unsigned x, unsigned& nloc, unsigned& nx) {
    const unsigned G = gridDim.x * gridDim.y * gridDim.z;
    unsigned sum, cnt, mine, sp = 0u;
    for (;;) {
        sum = 0u; cnt = 0u; mine = 0u;
#pragma unroll
        for (unsigned j = 0; j < 16; ++j) { const unsigned c = xb_ld(&bar[XB_XCNT(j)]); sum += c; cnt += (c > 0u) ? 1u : 0u; mine = (j == x) ? c : mine; }
        if (sum == G) break;
        __builtin_amdgcn_s_sleep(1);
        if ((++sp & 255u) == 0u) { if (xb_ld(&bar[XB_TMO])) break; if (sp > XB_SPIN_CAP) { atomicAdd(&bar[XB_TMO], 1u); break; } }
    }
    nloc = mine > 0u ? mine : 1u; nx = cnt > 0u ? cnt : 1u;
}
__device__ __forceinline__ void xcd_barrier(const XcdBarrier& b, const int tid) {
    asm volatile("s_waitcnt vmcnt(0)" ::: "memory");
    __syncthreads();
    if (tid == 0) {
        unsigned* bar = b.bar;
        __builtin_amdgcn_s_waitcnt(0);
        unsigned nloc = b.st[0], nx = b.st[1];
        if (nloc == 0u) { xcd_barrier_complete(bar, b.x, nloc, nx); b.st[0] = nloc; b.st[1] = nx; }
        const unsigned old = xb_add(&bar[XB_XSUB(b.x)], 1u);
        const unsigned gen = old / nloc;
        if (old + 1u == (gen + 1u) * nloc) {
            __builtin_amdgcn_fence(__ATOMIC_RELEASE, "agent");
            asm volatile("s_waitcnt vmcnt(0)" ::: "memory");
            const unsigned og = xb_add(&bar[XB_TOP], 1u);
            const unsigned tg = og / nx;
            if (og + 1u == (tg + 1u) * nx) xb_add(&bar[XB_TOPGEN], 1u);
            else XB_SPIN(xb_ld(&bar[XB_TOPGEN]) == tg, bar);
            __builtin_amdgcn_fence(__ATOMIC_ACQUIRE, "agent");
            xb_add(&bar[XB_XGEN(b.x)], 1u);
            asm volatile("s_waitcnt vmcnt(0)" ::: "memory");
        } else {
            XB_SPIN(xb_ld(&bar[XB_XGEN(b.x)]) == gen, bar);
            __builtin_amdgcn_fence(__ATOMIC_ACQUIRE, "agent");
            asm volatile("s_waitcnt vmcnt(0)" ::: "memory");
        }
    }
    __syncthreads();
}

namespace pg8 {
constexpr int BM = 256, BK = 64, HALF = 128, HTB = HALF * BK * 2, STAGE_BYTES = 8 * HTB, NXCD = 8, WGM = 8;
__host__ __device__ __forceinline__ int lds_byte(int r, int c) { const int st = (r >> 4) * 2 + (c >> 5), rr = r & 15, cc = c & 31, ob = rr * 64 + cc * 2; return st * 1024 + (ob ^ (((ob >> 9) & 1) << 5)); }
__host__ __device__ __forceinline__ void stage_rc(int b, int& R, int& C) { const int st = b / 1024, sb = b % 1024, swz = sb ^ (((sb >> 9) & 1) << 5); R = (st >> 1) * 16 + swz / 64; C = (st & 1) * 32 + (swz % 64) / 2; }
__host__ __device__ __forceinline__ int perm32(int rho) { const int n = rho >> 4, i = rho & 15; return 8 * (i >> 2) + 4 * n + (i & 3); }

__device__ __forceinline__ i32x8 f8op(bf16x8 lo, bf16x8 hi) { const i32x4 a = __builtin_bit_cast(i32x4, lo), b = __builtin_bit_cast(i32x4, hi); return (i32x8){a[0], a[1], a[2], a[3], b[0], b[1], b[2], b[3]}; }
struct Unit { int pm, pn; const char* A; const char* B; };

__device__ __forceinline__ void order_map(int L, int nM, int nN, int& pm, int& pn) {
    const int nwg = nM * nN; int wgid = L;
    { const int q = nwg / NXCD, r = nwg % NXCD, xcd = wgid % NXCD, off = wgid / NXCD; wgid = (xcd < r ? xcd * (q + 1) : r * (q + 1) + (xcd - r) * q) + off; }
    const int nig = WGM * nN, gid = wgid / nig, fm = gid * WGM, gsz = (nM - fm) < WGM ? (nM - fm) : WGM;
    pm = fm + ((wgid % nig) % gsz); pn = (wgid % nig) / gsz;
}

template <class Epi, class Sched, bool GATHER, bool F8 = false>
__device__ __forceinline__ void gemm_phase(LAS unsigned char* lds, const int Kel, const Sched& S, const Epi& E, const int wid_in  ) {
    const int K = F8 ? Kel / 2 : Kel;
    int wid = wid_in; asm volatile("" : "+s"(wid));
    const int lane = lane_id_now(), tid = wid * 64 + lane;
    const int wr = wid >> 2, wc = wid & 3, fr = lane & 15, fq = lane >> 4;
    const int nt = K / BK;
    unsigned voffB[2], vA0[2], vA1[2];
    const size_t hstep = (size_t)HALF * K * 2;
#pragma unroll
    for (int i = 0; i < 2; ++i) { int R, C; stage_rc(tid * 16 + i * 8192, R, C); const int Rb = Epi::PERM ? ((R & ~31) + perm32(R & 31)) : R;
        voffB[i] = (unsigned)(Rb * K + C) * 2u; vA0[i] = (unsigned)(R * K + C) * 2u; vA1[i] = vA0[i] + (unsigned)hstep; }
    const size_t kstep = (size_t)(BK * 2);
    const unsigned ldsw = (unsigned)wid * 1024u;
    const int aoff = lds_byte(wr * 64 + fr, F8 ? fq * 16 : fq * 8), boff = lds_byte(wc * 32 + fr, F8 ? fq * 16 : fq * 8);
#define PG8_SA(b, h) (((b) * 2 + (h)) * HTB)
#define PG8_SB(b, h) ((4 + (b) * 2 + (h)) * HTB)
#define PG8_STAGE(bufoff, gbase, voff) do { _Pragma("unroll") for (int _i = 0; _i < 2; ++_i) { \
        asm volatile("s_mov_b32 m0, %0\n\ts_nop 0\n\tglobal_load_lds_dwordx4 %1, %2" \
            :: "s"((unsigned)(uintptr_t)(lds + (bufoff) + _i * 8192) + ldsw), "v"((voff)[_i]), "s"((const char*)(gbase)) : "memory"); } } while (0)
#define PG8_STAGE_SEL(bufoff, gbase, sel, vn, vc) do { _Pragma("unroll") for (int _i = 0; _i < 2; ++_i) \
        __builtin_amdgcn_global_load_lds((const unsigned*)((const char*)(gbase) + ((sel) ? (vn)[_i] : (vc)[_i])), (LAS unsigned*)(lds + (bufoff) + ldsw + _i * 8192), 16, 0, 0); } while (0)
#define PG8_LD8(p) __builtin_shufflevector(*(const LAS i32x4*)(p), *(const LAS i32x4*)((p) + 16), 0, 1, 2, 3, 4, 5, 6, 7)
#define PG8_LDA(dst, b, h) do { if constexpr (F8) { _Pragma("unroll") for (int m = 0; m < 4; ++m) dst##8[m] = PG8_LD8(lds + PG8_SA(b, h) + aoff + m * 2048); } \
        else { _Pragma("unroll") for (int m = 0; m < 4; ++m) _Pragma("unroll") for (int k = 0; k < 2; ++k) dst[m][k] = *(const LAS bf16x8*)(lds + PG8_SA(b, h) + aoff + m * 2048 + k * 1024); } } while (0)
#define PG8_LDB(dst, b, h) do { if constexpr (F8) { _Pragma("unroll") for (int n = 0; n < 2; ++n) dst##8[n] = PG8_LD8(lds + PG8_SB(b, h) + boff + n * 2048); } \
        else { _Pragma("unroll") for (int n = 0; n < 2; ++n) _Pragma("unroll") for (int k = 0; k < 2; ++k) dst[n][k] = *(const LAS bf16x8*)(lds + PG8_SB(b, h) + boff + n * 2048 + k * 1024); } } while (0)
#define PG8_MMA(ai, bj, At, Bt) do { __builtin_amdgcn_s_setprio(1); if constexpr (F8) { _Pragma("unroll") for (int m = 0; m < 4; ++m) _Pragma("unroll") for (int n = 0; n < 2; ++n) \
            acc[ai][bj][m][n] = __builtin_amdgcn_mfma_scale_f32_16x16x128_f8f6f4(Bt##8[n], At##8[m], acc[ai][bj][m][n], 0, 0, 0, 0x7A7A7A7A, 0, 0x7A7A7A7A); } \
        else { _Pragma("unroll") for (int m = 0; m < 4; ++m) _Pragma("unroll") for (int n = 0; n < 2; ++n) _Pragma("unroll") for (int k = 0; k < 2; ++k) \
            acc[ai][bj][m][n] = __builtin_amdgcn_mfma_f32_16x16x32_bf16(Bt[n][k], At[m][k], acc[ai][bj][m][n], 0, 0, 0); } __builtin_amdgcn_s_setprio(0); } while (0)
#define PG8_WAIT_V(n) asm volatile("s_waitcnt vmcnt(" #n ")" ::: "memory")
#define PG8_WAIT_L(n) asm volatile("s_waitcnt lgkmcnt(" #n ")" ::: "memory")
#define PG8_BAR __builtin_amdgcn_s_barrier()
#define PG8_SCHED __builtin_amdgcn_sched_barrier(0)
    Unit cur, nxt; int ui = 0;
    if (!S.next(0, cur)) return;
    f32x4 acc[2][2][4][2];
    if constexpr (Epi::INIT) { const int l2 = lane_id_now(); const typename Epi::PreT pr0 = E.pre(cur, wr, wc, l2 & 15, l2 >> 4); E.init(acc, pr0); }
    else {
#pragma unroll
    for (int a = 0; a < 2; ++a)
#pragma unroll
        for (int b = 0; b < 2; ++b)
#pragma unroll
            for (int m = 0; m < 4; ++m)
#pragma unroll
                for (int n = 0; n < 2; ++n) { float z = 0.f; asm volatile("" : "+v"(z)); acc[a][b][m][n] = (f32x4){z, z, z, z}; }
    }
    bf16x8 At[4][2], B0[2][2], B1[2][2]; i32x8 At8[4], B08[2], B18[2];
    const char* cA = cur.A; const char* cB = cur.B;
    if constexpr (GATHER) {
#pragma unroll
        for (int i = 0; i < 2; ++i) { int R, C; stage_rc(tid * 16 + i * 8192, R, C); vA0[i] = S.row_off(cur, R) + (unsigned)C * 2u; vA1[i] = S.row_off(cur, HALF + R) + (unsigned)C * 2u; }
    }
    PG8_STAGE(PG8_SB(0, 0), cB, voffB); PG8_STAGE(PG8_SB(0, 1), cB + hstep, voffB); PG8_STAGE(PG8_SA(0, 0), cA, vA0); PG8_STAGE(PG8_SA(0, 1), cA, vA1);
    if (wr == 1) PG8_BAR;
    PG8_WAIT_V(2); PG8_BAR;
    PG8_STAGE(PG8_SB(1, 0), cB + kstep, voffB); PG8_STAGE(PG8_SA(1, 0), cA + kstep, vA0); PG8_STAGE(PG8_SB(1, 1), cB + hstep + kstep, voffB);
    PG8_WAIT_V(6); PG8_BAR;
    for (;;) {
        const bool has_next = S.next(ui + 1, nxt);
        const char* nA = has_next ? nxt.A : cA; const char* nB = has_next ? nxt.B : cB;
#pragma nounroll
        for (int t = 0; t < nt; t += 2) {
            const bool last = (t == nt - 2);
            const char* a1 = cA + (size_t)(t + 1) * kstep;
            const char* a2 = last ? nA : cA + (size_t)(t + 2) * kstep; const char* b2 = last ? nB : cB + (size_t)(t + 2) * kstep;
            const char* a3 = a2 + kstep; const char* b3 = b2 + kstep;
            PG8_LDB(B0, 0, 0); PG8_LDB(B1, 0, 1); PG8_SCHED; PG8_LDA(At, 0, 0); PG8_STAGE(PG8_SA(1, 1), a1, vA1);
            if constexpr (GATHER) { if (last && has_next) {
#pragma unroll
                for (int i = 0; i < 2; ++i) { int R, C; stage_rc(tid * 16 + i * 8192, R, C); vA0[i] = S.row_off(nxt, R) + (unsigned)C * 2u; vA1[i] = S.row_off(nxt, HALF + R) + (unsigned)C * 2u; } } }
            PG8_WAIT_V(8); PG8_WAIT_L(0); PG8_BAR; PG8_MMA(0, 0, At, B0); PG8_MMA(0, 1, At, B1); PG8_BAR; PG8_SCHED;
            PG8_LDA(At, 0, 1); PG8_STAGE(PG8_SB(0, 0), b2, voffB); PG8_STAGE(PG8_SB(0, 1), b2 + hstep, voffB); PG8_STAGE(PG8_SA(0, 0), a2, vA0);
            PG8_WAIT_V(8); PG8_WAIT_L(0); PG8_BAR; PG8_MMA(1, 0, At, B0); PG8_MMA(1, 1, At, B1); PG8_BAR; PG8_SCHED;
            PG8_LDB(B0, 1, 0); PG8_LDB(B1, 1, 1); PG8_SCHED; PG8_LDA(At, 1, 0); PG8_STAGE(PG8_SA(0, 1), a2, vA1);
            PG8_WAIT_V(8); PG8_WAIT_L(0); PG8_BAR; PG8_MMA(0, 0, At, B0); PG8_MMA(0, 1, At, B1); PG8_BAR; PG8_SCHED;
            PG8_LDA(At, 1, 1); PG8_STAGE(PG8_SB(1, 0), b3, voffB); PG8_STAGE(PG8_SB(1, 1), b3 + hstep, voffB); PG8_STAGE(PG8_SA(1, 0), a3, vA0);
            PG8_WAIT_V(8); PG8_WAIT_L(0); PG8_BAR; PG8_MMA(1, 0, At, B0); PG8_MMA(1, 1, At, B1); PG8_BAR; PG8_SCHED;
        }
        if (wr == 0) PG8_BAR;
        typename Epi::PreT prn{};
        { const int l2 = lane_id_now();
          if constexpr (Epi::INIT) { if (has_next) prn = E.pre(nxt, wr, wc, l2 & 15, l2 >> 4); }
          E(acc, cur, wr, wc, l2 & 15, l2 >> 4); }
        if (!has_next) break;
        if constexpr (Epi::INIT) E.init(acc, prn);
        else {
#pragma unroll
        for (int a = 0; a < 2; ++a)
#pragma unroll
            for (int b = 0; b < 2; ++b)
#pragma unroll
                for (int m = 0; m < 4; ++m)
#pragma unroll
                    for (int n = 0; n < 2; ++n) { float z = 0.f; asm volatile("" : "+v"(z)); acc[a][b][m][n] = (f32x4){z, z, z, z}; }
        }
        cur = nxt; cA = nA; cB = nB; ++ui;
        if (wr == 1) PG8_BAR;
    }
    PG8_WAIT_V(0);
    PG8_BAR;
#undef PG8_SA
#undef PG8_SB
#undef PG8_STAGE
#undef PG8_STAGE_SEL
#undef PG8_LDA
#undef PG8_LDB
#undef PG8_MMA
#undef PG8_WAIT_V
#undef PG8_WAIT_L
#undef PG8_BAR
#undef PG8_SCHED
}
}

namespace att {
#define SBAR() __builtin_amdgcn_sched_barrier(0)
__device__ __forceinline__ int crow(int r, int hi) { return (r & 3) + 8 * (r >> 2) + 4 * hi; }
template <int OFF> __device__ __forceinline__ s16x4 tr_read(int vb) {
    s16x4 r; asm volatile("ds_read_b64_tr_b16 %0, %1 offset:%2" : "=&v"(r) : "v"(vb), "i"(OFF) : "memory"); return r;
}
__device__ __forceinline__ int v_rd_base(int lane) { return ((lane & 3) << 3) | (((lane >> 2) & 3) << 6) | (((lane >> 4) & 1) << 5) | (((lane >> 5) & 1) << 8); }

template <int DQK, int DV, bool MASK, bool SINK> struct Body {
    static constexpr int KROW = DQK * 2, SHM_K = 64 * DQK * 2, SHM_V = 64 * DV * 2, NKC = 64 * DQK / 8 / 512, NVC = 64 * DV / 8 / 512, ND0 = DV / 32, NQ = DQK / 16;
    static constexpr int VU = (DV / 32) * 512;
    static constexpr int NQL = (DQK > 64) ? 4 : 0, NQR = NQ - NQL;
    static constexpr int QL_OFF = 2 * SHM_K + 2 * SHM_V + NWAVES * 64 * 4, LDS_NEED = QL_OFF + NWAVES * NQL * 64 * 16;
    static constexpr float SCALE = (DQK == 192) ? 0.07216878364870322f : 0.125f;
    static constexpr float THR = 8.f;
    static __device__ __forceinline__ int kswz(int row, int colB) { return row * KROW + (colB ^ (((row >> 1) & 7) << 4)); }
    static __device__ __forceinline__ int v_st(int k, int c) { const int kk = (k & ~0xC) | ((k & 4) << 1) | ((k & 8) >> 1); return ((kk >> 3) * ND0 + (c >> 5)) * 512 + ((kk & 7) * 32 + (c & 31)) * 2; }
    static constexpr int v_rd_off(int d0, int ks, int half) { return d0 * 512 + ks * (2 * VU) + half * VU; }

    static __device__ __forceinline__ void partialSM(f32x16& p0, f32x16& p1, float& m_reg, float& mn, float& alpha, bool domask, int drel, int hi) {
        constexpr float C = SCALE * 1.4426950408889634f;
        if (MASK) { if (domask) {
#pragma unroll
            for (int r = 0; r < 16; ++r) { const int rel = drel + crow(r, hi); if ((unsigned)(rel + 128) > 256u) p0[r] = -INFINITY; if ((unsigned)(rel + 32 + 128) > 256u) p1[r] = -INFINITY; }
        } }
        float pmax = p0[0];
#pragma unroll
        for (int r = 1; r < 16; ++r) pmax = fmaxf(pmax, p0[r]);
#pragma unroll
        for (int r = 0; r < 16; ++r) pmax = fmaxf(pmax, p1[r]);
        { unsigned xa = __float_as_uint(pmax), xb = xa; asm volatile("" : "+v"(xb));
          auto rr = __builtin_amdgcn_permlane32_swap(xa, xb, false, false);
          pmax = fmaxf(__uint_as_float(rr[0]), __uint_as_float(rr[1])); }
        if (__builtin_expect(__all(pmax - m_reg <= THR / SCALE), 1)) { mn = m_reg; alpha = 1.f; }
        else { mn = fmaxf(m_reg, pmax); alpha = __builtin_amdgcn_exp2f((m_reg - mn) * C); m_reg = mn; }
        const float mnC = -mn * C;
#pragma unroll
        for (int r = 0; r < 16; ++r) p0[r] = fmaf(p0[r], C, mnC);
#pragma unroll
        for (int r = 0; r < 16; ++r) p1[r] = fmaf(p1[r], C, mnC);
#pragma unroll
        for (int r = 0; r < 16; ++r) p0[r] = __builtin_amdgcn_exp2f(p0[r]);
    }
    static __device__ __forceinline__ void finishSM(f32x16& p0, f32x16& p1, float alpha, float& l_reg, bf16x8& pa0, bf16x8& pa1, bf16x8& pa2, bf16x8& pa3) {
#pragma unroll
        for (int r = 0; r < 16; ++r) p1[r] = __builtin_amdgcn_exp2f(p1[r]);
        float ps = 0;
#pragma unroll
        for (int r = 0; r < 16; ++r) ps += p0[r];
#pragma unroll
        for (int r = 0; r < 16; ++r) ps += p1[r];
        { unsigned xa = __float_as_uint(ps), xb = xa; asm volatile("" : "+v"(xb));
          auto rr = __builtin_amdgcn_permlane32_swap(xa, xb, false, false);
          ps = __uint_as_float(rr[0]) + __uint_as_float(rr[1]); }
        l_reg = l_reg * alpha + ps;
#define PK4(P, BASE, OUT) do { unsigned a0 = cvt_pk_bf16(P[BASE + 0], P[BASE + 1]), a1 = cvt_pk_bf16(P[BASE + 2], P[BASE + 3]);   \
    unsigned b0 = cvt_pk_bf16(P[BASE + 4], P[BASE + 5]), b1 = cvt_pk_bf16(P[BASE + 6], P[BASE + 7]);                              \
    auto r0 = __builtin_amdgcn_permlane32_swap(a0, b0, false, false); auto r1 = __builtin_amdgcn_permlane32_swap(a1, b1, false, false); \
    u32x4 w = {r0[0], r1[0], r0[1], r1[1]}; OUT = *reinterpret_cast<bf16x8*>(&w); } while (0)
        PK4(p0, 0, pa0); PK4(p0, 8, pa1); PK4(p1, 0, pa2); PK4(p1, 8, pa3);
#undef PK4
    }
    template <int D0> static __device__ __forceinline__ void qk_steps(f32x16& p0, f32x16& p1, bf16x8 ka0, bf16x8 ka1, bf16x8 qa, const LAS char* Ks, const int (&kb)[4], const bf16x8* qr, const LAS char* ql) {
        bf16x8 kn0 = ka0, kn1 = ka1, qn = qa;
        if constexpr (D0 + 1 < NQ) { constexpr int d1 = D0 + 1;
            kn0 = *reinterpret_cast<const LAS bf16x8*>(Ks + kb[d1 & 3] + (d1 >> 2) * 128);
            kn1 = *reinterpret_cast<const LAS bf16x8*>(Ks + kb[d1 & 3] + (d1 >> 2) * 128 + 32 * KROW);
            if constexpr (d1 < NQR) qn = qr[d1]; else qn = *reinterpret_cast<const LAS bf16x8*>(ql + (d1 - NQR) * 1024); }
        p0 = __builtin_amdgcn_mfma_f32_32x32x16_bf16(ka0, qa, p0, 0, 0, 0);
        p1 = __builtin_amdgcn_mfma_f32_32x32x16_bf16(ka1, qa, p1, 0, 0, 0);
        if constexpr (D0 + 1 < NQ) {
            __builtin_amdgcn_sched_group_barrier(0x100, (D0 + 1 >= NQR) ? 3 : 2, 0);
            __builtin_amdgcn_sched_group_barrier(0x008, 2, 0);
            qk_steps<D0 + 1>(p0, p1, kn0, kn1, qn, Ks, kb, qr, ql);
        } else { __builtin_amdgcn_sched_group_barrier(0x008, 2, 0); }
    }
    static __device__ __forceinline__ void qkt(f32x16& p0, f32x16& p1, const LAS char* Ks, const int (&kb)[4], const bf16x8* qr, const LAS char* ql) {
        p0 = f32x16{}; p1 = f32x16{};
        const bf16x8 ka0 = *reinterpret_cast<const LAS bf16x8*>(Ks + kb[0]), ka1 = *reinterpret_cast<const LAS bf16x8*>(Ks + kb[0] + 32 * KROW);
        bf16x8 qa; if constexpr (0 < NQR) qa = qr[0]; else qa = *reinterpret_cast<const LAS bf16x8*>(ql);
        __builtin_amdgcn_sched_group_barrier(0x100, (0 < NQR) ? 2 : 3, 0);
        qk_steps<0>(p0, p1, ka0, ka1, qa, Ks, kb, qr, ql);
    }
    struct VF { s16x4 l0, h0, l1, h1, l2, h2, l3, h3; };
    template <int D0> static __device__ __forceinline__ VF v_reads(int vb) {
        VF f; f.l0 = tr_read<v_rd_off(D0, 0, 0)>(vb); f.h0 = tr_read<v_rd_off(D0, 0, 1)>(vb); f.l1 = tr_read<v_rd_off(D0, 1, 0)>(vb); f.h1 = tr_read<v_rd_off(D0, 1, 1)>(vb);
        f.l2 = tr_read<v_rd_off(D0, 2, 0)>(vb); f.h2 = tr_read<v_rd_off(D0, 2, 1)>(vb); f.l3 = tr_read<v_rd_off(D0, 3, 0)>(vb); f.h3 = tr_read<v_rd_off(D0, 3, 1)>(vb); return f; }
    static __device__ __forceinline__ void pv_mma(f32x16& od, const VF& f, bf16x8 pa0, bf16x8 pa1, bf16x8 pa2, bf16x8 pa3) {
#define PK(L, H) (bf16x8){L[0], L[1], L[2], L[3], H[0], H[1], H[2], H[3]}
        od = __builtin_amdgcn_mfma_f32_32x32x16_bf16(pa0, PK(f.l0, f.h0), od, 0, 0, 0);
        od = __builtin_amdgcn_mfma_f32_32x32x16_bf16(pa1, PK(f.l1, f.h1), od, 0, 0, 0);
        od = __builtin_amdgcn_mfma_f32_32x32x16_bf16(pa2, PK(f.l2, f.h2), od, 0, 0, 0);
        od = __builtin_amdgcn_mfma_f32_32x32x16_bf16(pa3, PK(f.l3, f.h3), od, 0, 0, 0);
#undef PK
    }
    static __device__ __forceinline__ void pv_d0(f32x16* o, int vb, bf16x8 pa0, bf16x8 pa1, bf16x8 pa2, bf16x8 pa3) {
        const VF f0 = v_reads<0>(vb); const VF f1 = v_reads<1>(vb);
        asm volatile("s_waitcnt lgkmcnt(8)" ::: "memory"); SBAR();
        pv_mma(o[0], f0, pa0, pa1, pa2, pa3);
        if constexpr (ND0 == 4) {
            SBAR(); const VF f2 = v_reads<2>(vb);
            asm volatile("s_waitcnt lgkmcnt(8)" ::: "memory"); SBAR();
            pv_mma(o[1], f1, pa0, pa1, pa2, pa3);
            SBAR(); const VF f3 = v_reads<3>(vb);
            asm volatile("s_waitcnt lgkmcnt(8)" ::: "memory"); SBAR();
            pv_mma(o[2], f2, pa0, pa1, pa2, pa3);
            asm volatile("s_waitcnt lgkmcnt(0)" ::: "memory"); SBAR();
            pv_mma(o[3], f3, pa0, pa1, pa2, pa3);
        } else {
            asm volatile("s_waitcnt lgkmcnt(0)" ::: "memory"); SBAR();
            pv_mma(o[1], f1, pa0, pa1, pa2, pa3);
        }
    }

    static __device__ __forceinline__ void run(const bf16* Qb, const bf16* Kh, const bf16* Vh, bf16* Ob, int NT, int lrow0, int q0, int lo, float sinkv, LAS unsigned char* ldsu, const int wid  ,
                                              const int qstride = DQK, const float* qg = nullptr, const float* ropec = nullptr, const float* ropes = nullptr, const int qpos0 = 0, const bool qrope = false, const float* mq = nullptr) {
        const int lane = lane_id_now(), tid = wid * 64 + lane, r32 = lane & 31, hi = lane >> 5;
        LAS char* lds = (LAS char*)ldsu; LAS char* V_lds = lds; LAS char* K_lds = lds + 2 * SHM_V;
        LAS float* wsf = (LAS float*)(lds + 2 * SHM_V + 2 * SHM_K) + wid * 64; LAS float* li_l = wsf; LAS float* al_l = wsf + 32;
        int kb[4];
#pragma unroll
        for (int r = 0; r < 4; ++r) kb[r] = r32 * KROW + ((r * 32 + hi * 16) ^ (((r32 >> 1) & 7) << 4));
        float m_reg = -1e30f, l_reg = 0; f32x16 o[ND0]; bf16x8 qr[NQR > 0 ? NQR : 1];
        LAS char* ql = lds + QL_OFF + (wid * NQL * 64 + lane) * 16;
        const bf16* Qw = Qb + (long)(wid * 32 + r32) * qstride + hi * 8;
        if constexpr (DQK == 192) {
            u32x4 qv[NQ];
#pragma unroll
            for (int d0 = 0; d0 < NQ; ++d0) qv[d0] = *(const GAS u32x4*)(Qw + d0 * 16);
            float ss = 0.f;
#pragma unroll
            for (int d0 = 0; d0 < NQ; ++d0)
#pragma unroll
                for (int w = 0; w < 4; ++w) { const float a = bflo(qv[d0][w]), b = bfhi(qv[d0][w]); ss += a * a + b * b; }
            ss += xhalf(ss);
            const f32x2 mqv = *(const GAS f32x2*)(mq + (size_t)(wid * 32 + r32) * 2);
            const float rstd = rsqrtf(ss * (1.f / 192.f) + EPS * ((mqv[0] + mqv[1]) * (1.f / 384.f) + EPS));
#pragma unroll
            for (int d0 = 0; d0 < 8; ++d0) { const f32x4 g0 = *(const GAS f32x4*)(qg + d0 * 16 + hi * 8), g1 = *(const GAS f32x4*)(qg + d0 * 16 + hi * 8 + 4);
                u32x4 w; w.x = cvt_pk_bf16(bflo(qv[d0].x) * rstd * g0[0], bfhi(qv[d0].x) * rstd * g0[1]); w.y = cvt_pk_bf16(bflo(qv[d0].y) * rstd * g0[2], bfhi(qv[d0].y) * rstd * g0[3]);
                w.z = cvt_pk_bf16(bflo(qv[d0].z) * rstd * g1[0], bfhi(qv[d0].z) * rstd * g1[1]); w.w = cvt_pk_bf16(bflo(qv[d0].w) * rstd * g1[2], bfhi(qv[d0].w) * rstd * g1[3]);
                qr[d0] = __builtin_bit_cast(bf16x8, w); }
            const int qpos = qpos0 + wid * 32 + r32;
#pragma unroll
            for (int a = 0; a < 2; ++a) { const u32x4 x1 = qv[8 + 2 * a], x2 = qv[9 + 2 * a];
                const float* ga = qg + 128 + a * 32 + hi * 8;
                float n1[8], n2[8];
#pragma unroll
                for (int hq = 0; hq < 2; ++hq) { const f32x4 g1 = *(const GAS f32x4*)(ga + hq * 4), g2 = *(const GAS f32x4*)(ga + 16 + hq * 4);
                    const unsigned u1a = hq ? x1.z : x1.x, u1b = hq ? x1.w : x1.y, u2a = hq ? x2.z : x2.x, u2b = hq ? x2.w : x2.y;
                    n1[hq * 4 + 0] = bflo(u1a) * rstd * g1[0]; n1[hq * 4 + 1] = bfhi(u1a) * rstd * g1[1]; n1[hq * 4 + 2] = bflo(u1b) * rstd * g1[2]; n1[hq * 4 + 3] = bfhi(u1b) * rstd * g1[3];
                    n2[hq * 4 + 0] = bflo(u2a) * rstd * g2[0]; n2[hq * 4 + 1] = bfhi(u2a) * rstd * g2[1]; n2[hq * 4 + 2] = bflo(u2b) * rstd * g2[2]; n2[hq * 4 + 3] = bfhi(u2b) * rstd * g2[3]; }
                if (qrope) {
#pragma unroll
                    for (int hq = 0; hq < 2; ++hq) { const f32x4 cv = *(const GAS f32x4*)(ropec + qpos * 32 + a * 16 + hi * 8 + hq * 4), sv = *(const GAS f32x4*)(ropes + qpos * 32 + a * 16 + hi * 8 + hq * 4);
#pragma unroll
                        for (int e = 0; e < 4; ++e) { const float y1 = n1[hq * 4 + e], y2 = n2[hq * 4 + e]; n1[hq * 4 + e] = y1 * cv[e] - y2 * sv[e]; n2[hq * 4 + e] = y1 * sv[e] + y2 * cv[e]; } } }
                u32x4 w1, w2; w1.x = cvt_pk_bf16(n1[0], n1[1]); w1.y = cvt_pk_bf16(n1[2], n1[3]); w1.z = cvt_pk_bf16(n1[4], n1[5]); w1.w = cvt_pk_bf16(n1[6], n1[7]);
                w2.x = cvt_pk_bf16(n2[0], n2[1]); w2.y = cvt_pk_bf16(n2[2], n2[3]); w2.z = cvt_pk_bf16(n2[4], n2[5]); w2.w = cvt_pk_bf16(n2[6], n2[7]);
                *reinterpret_cast<LAS u32x4*>(ql + (2 * a) * 1024) = w1; *reinterpret_cast<LAS u32x4*>(ql + (2 * a + 1) * 1024) = w2; }
        } else {
#pragma unroll
            for (int d0 = 0; d0 < NQ; ++d0) { const bf16x8 qv = *(const GAS bf16x8*)(Qw + d0 * 16); if (d0 < NQR) qr[d0] = qv; else *reinterpret_cast<LAS bf16x8*>(ql + (d0 - NQR) * 1024) = qv; }
        }
#pragma unroll
        for (int d = 0; d < ND0; ++d) { float z = 0.f; asm volatile("" : "+v"(z)); o[d] = (f32x16){z, z, z, z, z, z, z, z, z, z, z, z, z, z, z, z}; }
        int kg[NKC], kl[NKC], vg[NVC], vl[NVC];
#pragma unroll
        for (int i = 0; i < NKC; ++i) { const int id = tid + 512 * i, row = id / (DQK / 8), c8 = id % (DQK / 8); kg[i] = row * DQK + c8 * 8; kl[i] = kswz(row, c8 * 16); }
#pragma unroll
        for (int i = 0; i < NVC; ++i) { const int id = tid + 512 * i, row = id / (DV / 8), c8 = id % (DV / 8); vg[i] = row * DV + c8 * 8; vl[i] = v_st(row, c8 * 8); }
        const int vb0 = (int)(unsigned)(uintptr_t)V_lds + v_rd_base(lane);
        const int drel0 = lo - (q0 + wid * 32 + r32);
        struct { bf16x8 ks[NKC]; bf16x8 vs[NVC]; } sr_[2];
#define TROW(j) ((j) < 4 ? 64 * (j) : lrow0 + 64 * ((j) - 4))
#define SLOAD(i, j) do { const long _r = TROW(j); _Pragma("unroll") for (int _c = 0; _c < NKC; ++_c) sr_[i].ks[_c] = *(const GAS bf16x8*)(Kh + _r * DQK + kg[_c]); \
    _Pragma("unroll") for (int _c = 0; _c < NVC; ++_c) sr_[i].vs[_c] = *(const GAS bf16x8*)(Vh + _r * DV + vg[_c]); } while (0)
#define SWRITE(b, i) do { _Pragma("unroll") for (int _c = 0; _c < NVC; ++_c) *(LAS bf16x8*)(V_lds + (b) * SHM_V + vl[_c]) = sr_[i].vs[_c]; \
    _Pragma("unroll") for (int _c = 0; _c < NKC; ++_c) *(LAS bf16x8*)(K_lds + (b) * SHM_K + kl[_c]) = sr_[i].ks[_c]; } while (0)
#define RESC(a) do { if (__any((a) < 1.f)) { if (hi == 0) al_l[r32] = (a); asm volatile("s_waitcnt lgkmcnt(0)" ::: "memory"); \
    _Pragma("unroll") for (int d = 0; d < ND0; ++d) _Pragma("unroll") for (int r = 0; r < 16; ++r) o[d][r] *= al_l[crow(r, hi)]; } } while (0)
#define DREL(j) (drel0 + 64 * ((j) - 4))
        f32x16 p0, p1; float mn, al; bf16x8 pa0, pa1, pa2, pa3;
        constexpr int S0 = 0, S1 = 1;
#define COMPUTE(j, b) do { SBAR(); qkt(p0, p1, K_lds + (b) * SHM_K, kb, qr, ql); partialSM(p0, p1, m_reg, mn, al, (j) >= 4, DREL(j), hi); RESC(al); \
    finishSM(p0, p1, al, l_reg, pa0, pa1, pa2, pa3); SBAR(); pv_d0(o, vb0 + (b) * SHM_V, pa0, pa1, pa2, pa3); } while (0)
        if constexpr (DQK > 64) {
            SLOAD(S0, 0); asm volatile("s_waitcnt vmcnt(0)" ::: "memory"); SWRITE(0, S0); __syncthreads();
            for (int j = 0; j < NT; j += 2) {
                SLOAD(S1, j + 1);
                COMPUTE(j, 0);
                SWRITE(1, S1);
                __syncthreads();
                if (j + 2 < NT) SLOAD(S0, j + 2);
                COMPUTE(j + 1, 1);
                if (j + 2 < NT) SWRITE(0, S0);
                __syncthreads();
            }
        } else {
            SLOAD(S0, 0); asm volatile("s_waitcnt vmcnt(0)" ::: "memory"); SWRITE(0, S0); SLOAD(S1, 1); __syncthreads();
            for (int j = 0; j < NT; j += 2) {
                if (j + 2 < NT) SLOAD(S0, j + 2);
                COMPUTE(j, 0);
                SWRITE(1, S1);
                __syncthreads();
                if (j + 3 < NT) SLOAD(S1, j + 3);
                COMPUTE(j + 1, 1);
                if (j + 2 < NT) SWRITE(0, S0);
                __syncthreads();
            }
        }
#undef COMPUTE
        if (SINK) { constexpr float C = SCALE * 1.4426950408889634f; l_reg += __builtin_amdgcn_exp2f(sinkv * 1.4426950408889634f - m_reg * C); }
        if (hi == 0) li_l[r32] = l_reg; asm volatile("s_waitcnt lgkmcnt(0)" ::: "memory");
        float rli[16];
#pragma unroll
        for (int r = 0; r < 16; ++r) rli[r] = __builtin_amdgcn_rcpf(li_l[crow(r, hi)]);
        unsigned char* Ow = (unsigned char*)Ob + (long)(wid * 32) * 1024;
#pragma unroll
        for (int r = 0; r < 16; ++r) { const int orow = crow(r, hi);
#pragma unroll
            for (int d0 = 0; d0 < ND0; ++d0) { const float ov = o[d0][r] * rli[r]; ((GAS unsigned char*)Ow)[(long)orow * 1024 + d0 * 32 + r32] = (unsigned char)(__builtin_amdgcn_cvt_pk_fp8_f32(ov, ov, 0, false) & 0xff); } }
        __syncthreads();
#undef TROW
#undef SLOAD
#undef SWRITE
#undef RESC
#undef DREL
    }
};
}

struct Args {
    const float* in[29];
    float* out; unsigned char* ws;
    int ph_lo, ph_hi;
};
enum { I_X = 0, I_C, I_CTX, I_CCTX, I_N1G, I_N2G, I_WADA, I_BADA, I_WIN, I_QNORM, I_KVNORM, I_WUQ, I_WUKV, I_QHN, I_KHN, I_CONVW, I_CONVB, I_LNG, I_LNB,
       I_SQN, I_SKN, I_SINK, I_WOUT, I_RW, I_RB, I_W1, I_B1, I_W2, I_B2 };

typedef const float* cfp_t;
typedef const __attribute__((address_space(4))) cfp_t* KArgs;
struct Ctx {
    LAS unsigned char* lds; char* ldsg;
    int tid, lane, wave, G, vcu, gw, NGW;
    unsigned char* ws; KArgs in; float* out;
};
#define WSP(T, off) ((T*)(C.ws + (off)))

__device__ __forceinline__ void tok_info(int t, int& b, bool& isctx, int& pos, int& key) {
    if (t < TL) { b = t >> 11; pos = t & 2047; isctx = false; key = NCTX + pos; } else { const int tc = t - TL; b = tc >> 8; pos = tc & 255; isctx = true; key = pos; }
}

constexpr int NP_CQ = 256, NP_KROPE = 640, NP_PAD = 704;
__host__ __device__ constexpr int win_dstblk(int nb) { return nb < 4 ? nb : nb == 4 ? 10 : nb < 9 ? nb + 7 : nb < 15 ? nb - 5 : nb < 21 ? nb + 1 : nb < 23 ? nb + 3 : nb < 25 ? nb - 1 : nb + 1; }
__device__ __forceinline__ void cvt_item(const float* W, int K, int N, bf16* WT, int item, int lane, bool w1perm, LAS unsigned char* scr  , const float* kscale = nullptr  , const bool winperm = false) {
    const int nblk = N / 64, kb = item / nblk, nb = item - kb * nblk, k0 = 64 * kb, n0 = 64 * nb;
    const float* src = W + (size_t)k0 * N + n0 + lane;
    float v[64];
#pragma unroll
    for (int i = 0; i < 64; ++i) v[i] = __builtin_nontemporal_load(src + (size_t)i * N);
    if (kscale) {
#pragma unroll
        for (int i = 0; i < 64; ++i) v[i] *= kscale[k0 + i]; }
#pragma unroll
    for (int c = 0; c < 8; ++c) { u32x4 o; o.x = pk2(v[8 * c], v[8 * c + 1]); o.y = pk2(v[8 * c + 2], v[8 * c + 3]); o.z = pk2(v[8 * c + 4], v[8 * c + 5]); o.w = pk2(v[8 * c + 6], v[8 * c + 7]);
        *(LAS u32x4*)(scr + lane * 144 + c * 16) = o; }
    asm volatile("s_waitcnt lgkmcnt(0)" ::: "memory");
#pragma unroll
    for (int j = 0; j < 8; ++j) { const int row = j * 8 + (lane >> 3), ch = lane & 7, n = n0 + row;
        const int nd = w1perm ? (256 * (n >> 8) + 128 * (n & 1) + ((n >> 1) & 127)) : winperm ? (64 * win_dstblk(nb) + row) : n;
        const u32x4 o = *(const LAS u32x4*)(scr + row * 144 + ch * 16);
        *(GAS u32x4*)(WT + (size_t)nd * K + k0 + ch * 8) = o; }
    asm volatile("s_waitcnt lgkmcnt(0)" ::: "memory");
}
constexpr float YK_SCALE = 32.f;
constexpr float F8_WSCALE = 1024.f;
__device__ __forceinline__ unsigned pk4_f8(float a, float b, float c, float d) { int w = __builtin_amdgcn_cvt_pk_fp8_f32(a, b, 0, false); w = __builtin_amdgcn_cvt_pk_fp8_f32(c, d, w, true); return (unsigned)w; }
__device__ __forceinline__ void cvt_item_f8(const float* W, int K, int N, unsigned char* WT, int item, int lane, bool w1perm, LAS unsigned char* scr, const bool winperm = false) {
    const int nblk = N / 64, kb = item / nblk, nb = item - kb * nblk, k0 = 64 * kb, n0 = 64 * nb;
    const float* src = W + (size_t)k0 * N + n0 + lane;
    float v[64];
#pragma unroll
    for (int i = 0; i < 64; ++i) v[i] = __builtin_nontemporal_load(src + (size_t)i * N) * F8_WSCALE;
#pragma unroll
    for (int c = 0; c < 4; ++c) { u32x4 o; o.x = pk4_f8(v[16 * c], v[16 * c + 1], v[16 * c + 2], v[16 * c + 3]); o.y = pk4_f8(v[16 * c + 4], v[16 * c + 5], v[16 * c + 6], v[16 * c + 7]);
        o.z = pk4_f8(v[16 * c + 8], v[16 * c + 9], v[16 * c + 10], v[16 * c + 11]); o.w = pk4_f8(v[16 * c + 12], v[16 * c + 13], v[16 * c + 14], v[16 * c + 15]);
        *(LAS u32x4*)(scr + lane * 80 + c * 16) = o; }
    asm volatile("s_waitcnt lgkmcnt(0)" ::: "memory");
#pragma unroll
    for (int j = 0; j < 4; ++j) { const int row = j * 16 + (lane >> 2), ch = lane & 3, n = n0 + row;
        const int nd = w1perm ? (256 * (n >> 8) + 128 * (n & 1) + ((n >> 1) & 127)) : winperm ? (64 * win_dstblk(nb) + row) : n;
        const u32x4 o = *(const LAS u32x4*)(scr + row * 80 + ch * 16);
        *(GAS u32x4*)(WT + (size_t)nd * K + k0 + ch * 16) = o; }
    asm volatile("s_waitcnt lgkmcnt(0)" ::: "memory");
}
constexpr int CVT_I_IN = 16 * 27, CVT_I_KV = 4 * 16, CVT_I_Q = 6 * 12, CVT_I_O = 16 * 16, CVT_I_1 = 32 * 16 * 32, CVT_I_2 = 32 * 16 * 16, CVT_ITEMS = CVT_I_IN + CVT_I_KV + CVT_I_Q + CVT_I_O + CVT_I_1 + CVT_I_2;
__device__ __forceinline__ void cvt_layer_item(Ctx& C, int l, int r) {
    unsigned char* wb = C.ws + WS_W + (size_t)l * WB_LAYER; LAS unsigned char* scr = C.lds + C.wave * 9216;
    if (r < CVT_I_IN) { cvt_item_f8(C.in[I_WIN] + (size_t)l * 1024 * INC, 1024, INC, (unsigned char*)(wb + WB_IN), r, C.lane, false, scr, true); return; } r -= CVT_I_IN;
    if (r < CVT_I_KV) { cvt_item(C.in[I_WUKV] + (size_t)l * 256 * 1024, 256, 1024, (bf16*)(wb + WB_UKV), r, C.lane, false, scr); return; } r -= CVT_I_KV;
    if (r < CVT_I_Q) { cvt_item(C.in[I_WUQ] + (size_t)l * 384 * 768, 384, 768, (bf16*)(wb + WB_UQ), r, C.lane, false, scr, C.in[I_QNORM] + l * 384); return; } r -= CVT_I_Q;
    if (r < CVT_I_O) { cvt_item_f8(C.in[I_WOUT] + (size_t)l * 1024 * 1024, 1024, 1024, (unsigned char*)(wb + WB_OUT), r, C.lane, false, scr); return; } r -= CVT_I_O;
    if (r < CVT_I_1) { const int e = r / 512, ri = r % 512; cvt_item_f8(C.in[I_W1] + ((size_t)l * NE + e) * 1024 * 2048, 1024, 2048, (unsigned char*)(wb + WB_W1) + (size_t)e * 2048 * 1024, ri, C.lane, true, scr); return; } r -= CVT_I_1;
    { const int e = r / 256, ri = r % 256; cvt_item_f8(C.in[I_W2] + ((size_t)l * NE + e) * 1024 * 1024, 1024, 1024, (unsigned char*)(wb + WB_W2) + (size_t)e * 1024 * 1024, ri, C.lane, false, scr); }
}
constexpr int CVT_Q6 = 6, CVT_Q7 = 4, CVT_Q9 = 2, CVT_Q10 = 2;
__device__ __forceinline__ void cvt_static(Ctx& C, int base, int j, int nj, int q) {
    for (int k = 0; k < q; ++k) { const int it = base + k * nj + j; if (it < CVT_ITEMS) cvt_layer_item(C, 1, it); }
}
__device__ __forceinline__ int cvt_n6() { return 224 * NWAVES * CVT_Q6; }
__device__ __forceinline__ int cvt_n7() { return 224 * NWAVES * CVT_Q7; }
__device__ __forceinline__ int cvt_idle(int nwg, int G) { const int rem = nwg % G; return rem ? G - rem : 0; }
__device__ __forceinline__ void p0_prologue(Ctx& C) {
    if (C.vcu < 192) {
        const int l = C.vcu / 96, c0 = (C.vcu % 96) * 64;
        float* s = (float*)C.ldsg;
        float* part = (float*)(C.ldsg + 49152);
        const float* cin = C.in[I_C]; const float* cctx = C.in[I_CCTX];
        for (int i = C.tid; i < 9 * 1024; i += NTHREADS) { const int r = i >> 10, k = i & 1023; const float c = r < 8 ? cin[r * 1024 + k] : cctx[k]; s[k * 12 + r] = c / (1.f + __expf(-c)); }
        __syncthreads();
        const int col = C.tid & 63, kg = C.tid >> 6;
        const float* W = C.in[I_WADA] + (size_t)l * 1024 * 6144 + c0 + col;
        float acc[9];
#pragma unroll
        for (int r = 0; r < 9; ++r) acc[r] = 0.f;
#pragma unroll 16
        for (int kk = 0; kk < 128; ++kk) { const int k = kg * 128 + kk; const float w = W[(size_t)k * 6144];
            const f32x4 s0 = *(const f32x4*)&s[k * 12], s1 = *(const f32x4*)&s[k * 12 + 4]; const float s2 = s[k * 12 + 8];
            acc[0] += w * s0[0]; acc[1] += w * s0[1]; acc[2] += w * s0[2]; acc[3] += w * s0[3]; acc[4] += w * s1[0]; acc[5] += w * s1[1]; acc[6] += w * s1[2]; acc[7] += w * s1[3]; acc[8] += w * s2; }
#pragma unroll
        for (int r = 0; r < 9; ++r) part[(kg * 9 + r) * 64 + col] = acc[r];
        __syncthreads();
        float* ada = WSP(float, WS_ADA);
        for (int i = C.tid; i < 9 * 64; i += NTHREADS) { const int r = i >> 6, c = i & 63; float a = C.in[I_BADA][l * 6144 + c0 + c];
#pragma unroll
            for (int g = 0; g < 8; ++g) a += part[(g * 9 + r) * 64 + c];
            ada[(size_t)(l * 9 + r) * 6144 + c0 + c] = a; }
        __syncthreads();
    }
    {
        float* ct = WSP(float, WS_ROPE); float* st = ct + 2048 * 32;
        for (int i = C.vcu * NTHREADS + C.tid; i < 2048 * 32; i += C.G * NTHREADS) { const int n = i >> 5, a = (i >> 4) & 1, j = i & 15;
            const float pos = (float)(a ? (n & 63) : (n >> 6)); const float inv = powf(10000.f, -(float)j / 16.f); const float ang = pos * inv;
            ct[i] = cosf(ang); st[i] = sinf(ang); }
    }
    {
        for (int it = C.gw; it < CVT_ITEMS; it += C.NGW) cvt_layer_item(C, 0, it);
        for (int l = 0; l < NLAYER; ++l) { u32x4* z = (u32x4*)(C.ws + WS_W + (size_t)l * WB_LAYER + WB_IN + (size_t)NP_PAD * 1024);
            unsigned zz = 0u; asm volatile("" : "+v"(zz));
            for (int i = C.vcu * NTHREADS + C.tid; i < 64 * 1024 / 16; i += C.G * NTHREADS) z[i] = (u32x4){zz, zz, zz, zz}; }
    }
}

template <int TP> __device__ __forceinline__ void norm1_phase_t(Ctx& C, int l) {
    const float* ada = WSP(float, WS_ADA); bf16* H = WSP(bf16, WS_H); const bf16* YK = WSP(bf16, WS_YK);
    const float* ng = C.in[I_N1G] + l * 1024; const int lane = C.lane;
    for (int t0 = C.gw * TP; t0 < NTOK; t0 += C.NGW * TP) {
        f32x4 v[TP][4]; unsigned yk[TP][4][4];
#pragma unroll
        for (int i = 0; i < TP; ++i) { const int t = t0 + i; const bool isctx = t >= TL;
            if (l == 0) { const float* xin = isctx ? C.in[I_CTX] + (size_t)(t - TL) * DM : C.in[I_X] + (size_t)t * DM;
#pragma unroll
                for (int j = 0; j < 4; ++j) v[i][j] = *((const GAS f32x4*)xin + lane + 64 * j); }
            else { const bf16* xin = WSP(bf16, WS_XS) + (size_t)t * DM;
#pragma unroll
                for (int j = 0; j < 4; ++j) { const u32x2 w = *((const GAS u32x2*)xin + lane + 64 * j); v[i][j] = (f32x4){bflo(w.x), bfhi(w.x), bflo(w.y), bfhi(w.y)}; } }
            if (l > 0) {
#pragma unroll
                for (int j = 0; j < 4; ++j)
#pragma unroll
                    for (int k = 0; k < 4; ++k) yk[i][j][k] = *((const GAS unsigned*)((const unsigned char*)YK + (size_t)(t * 4 + k) * 1024) + lane + 64 * j); } }
#pragma unroll
        for (int i = 0; i < TP; ++i) { const int t = t0 + i; const bool isctx = t >= TL; const int r = isctx ? 8 : (t >> 11);
            if (l > 0) { bf16* xst = WSP(bf16, WS_XS) + (size_t)t * DM;
                const float* g2 = ada + (size_t)((l - 1) * 9 + r) * 6144 + 5 * 1024;
#pragma unroll
                for (int j = 0; j < 4; ++j) { f32x4 y = (f32x4){0.f, 0.f, 0.f, 0.f};
#pragma unroll
                    for (int k = 0; k < 4; ++k) { const unsigned w = yk[i][j][k]; const f32x2 lo = __builtin_amdgcn_cvt_pk_f32_fp8((int)w, false), hi = __builtin_amdgcn_cvt_pk_f32_fp8((int)w, true); y[0] += lo[0]; y[1] += lo[1]; y[2] += hi[0]; y[3] += hi[1]; }
                    const f32x4 g = *((const GAS f32x4*)g2 + lane + 64 * j) * (1.f / YK_SCALE); v[i][j] = v[i][j] + g * y;
                    u32x2 xw; xw.x = cvt_pk_bf16(v[i][j][0], v[i][j][1]); xw.y = cvt_pk_bf16(v[i][j][2], v[i][j][3]); *((GAS u32x2*)xst + lane + 64 * j) = xw;
                    v[i][j] = (f32x4){bflo(xw.x), bfhi(xw.x), bflo(xw.y), bfhi(xw.y)}; } }
            float ss = 0.f;
#pragma unroll
            for (int j = 0; j < 4; ++j) ss += (v[i][j][0] * v[i][j][0] + v[i][j][1] * v[i][j][1]) + (v[i][j][2] * v[i][j][2] + v[i][j][3] * v[i][j][3]);
            const float rstd = rsqrtf(wave_sum(ss) * (1.f / DM) + EPS);
            const float* sh = ada + (size_t)(l * 9 + r) * 6144; const float* sc = sh + 1024;
#pragma unroll
            for (int j = 0; j < 4; ++j) { const f32x4 g = *((const GAS f32x4*)ng + lane + 64 * j), a = *((const GAS f32x4*)sc + lane + 64 * j), sv = *((const GAS f32x4*)sh + lane + 64 * j);
                const f32x4 h = v[i][j] * rstd * g * (a + 1.f) + sv; *((GAS unsigned*)((unsigned char*)H + (size_t)t * DM) + lane + 64 * j) = pk4_f8(h[0], h[1], h[2], h[3]); } }
    }
}
__device__ __forceinline__ void norm1_phase(Ctx& C, int l) { if (l == 0) norm1_phase_t<3>(C, 0); else norm1_phase_t<3>(C, l); }
__device__ __forceinline__ void final_phase(Ctx& C) {
    const float* ada = WSP(float, WS_ADA); const bf16* YK = WSP(bf16, WS_YK); const int lane = C.lane;
    constexpr int TP = 4;
    for (int t0 = C.gw * TP; t0 < TL; t0 += C.NGW * TP) {
        f32x4 x[TP][4]; unsigned yk[TP][4][4];
#pragma unroll
        for (int i = 0; i < TP; ++i) { const int t = t0 + i;
#pragma unroll
            for (int j = 0; j < 4; ++j) { { const u32x2 w = *((const GAS u32x2*)(WSP(bf16, WS_XS) + (size_t)t * DM) + lane + 64 * j); x[i][j] = (f32x4){bflo(w.x), bfhi(w.x), bflo(w.y), bfhi(w.y)}; }
#pragma unroll
                for (int k = 0; k < 4; ++k) yk[i][j][k] = *((const GAS unsigned*)((const unsigned char*)YK + (size_t)(t * 4 + k) * 1024) + lane + 64 * j); } }
#pragma unroll
        for (int i = 0; i < TP; ++i) { const int t = t0 + i; const float* g2 = ada + (size_t)(9 + (t >> 11)) * 6144 + 5 * 1024;
#pragma unroll
            for (int j = 0; j < 4; ++j) { f32x4 y = (f32x4){0.f, 0.f, 0.f, 0.f};
#pragma unroll
                for (int k = 0; k < 4; ++k) { const unsigned w = yk[i][j][k]; const f32x2 lo = __builtin_amdgcn_cvt_pk_f32_fp8((int)w, false), hi = __builtin_amdgcn_cvt_pk_f32_fp8((int)w, true); y[0] += lo[0]; y[1] += lo[1]; y[2] += hi[0]; y[3] += hi[1]; }
                const f32x4 g = *((const GAS f32x4*)g2 + lane + 64 * j) * (1.f / YK_SCALE); *((GAS f32x4*)(C.out + (size_t)t * DM) + lane + 64 * j) = x[i][j] + g * y; } }
    }
}

__device__ __forceinline__ f32x4 rope4(f32x4 v, const float* ct, const float* st, int n, int lane) {
    const int a = (lane & 15) >> 3, half = (lane & 7) >> 2, j0 = 4 * (lane & 3);
    const f32x4 c = *(const f32x4*)(ct + n * 32 + a * 16 + j0), s = *(const f32x4*)(st + n * 32 + a * 16 + j0);
    f32x4 o; o[0] = swz_xor<4>(v[0]); o[1] = swz_xor<4>(v[1]); o[2] = swz_xor<4>(v[2]); o[3] = swz_xor<4>(v[3]);
    return half ? (o * s + v * c) : (v * c - o * s);
}
__device__ __forceinline__ f32x2 rope2(f32x2 v, const float* ct, const float* st, int n, int lane) {
    const int l5 = lane & 31, a = l5 >> 4, half = (l5 & 15) >> 3, j0 = 2 * (l5 & 7);
    const f32x2 c = *(const f32x2*)(ct + n * 32 + a * 16 + j0), s = *(const f32x2*)(st + n * 32 + a * 16 + j0);
    f32x2 o; o[0] = swz_xor<8>(v[0]); o[1] = swz_xor<8>(v[1]);
    return half ? (o * s + v * c) : (v * c - o * s);
}
template <int TP> __device__ __forceinline__ void post_phase_t(Ctx& C, int l) {
    const bf16* P = WSP(bf16, WS_P); const float* ct = WSP(float, WS_ROPE); const float* st = ct + 2048 * 32;
    bf16* CKVN = WSP(bf16, WS_CKVN); float* MQ = WSP(float, WS_MQ); bf16* SK = WSP(bf16, WS_SK); bf16* SV = WSP(bf16, WS_SV); bf16* SQ = WSP(bf16, WS_SQ); bf16* U = WSP(bf16, WS_U);
    const int lane = C.lane; const bool last = (l == NLAYER - 1);
    const f32x4 gkv = *((const f32x4*)(C.in[I_KVNORM] + l * 256) + lane), gq = *((const f32x4*)(C.in[I_QNORM] + l * 384) + lane);
    const f32x2 gq2 = *((const f32x2*)(C.in[I_QNORM] + l * 384 + 256) + lane);
    const f32x4 gsk = *((const f32x4*)(C.in[I_SKN] + l * 64) + (lane & 15)), gsq = *((const f32x4*)(C.in[I_SQN] + l * 64) + (lane & 15));
    for (int t0 = C.gw * TP; t0 < NTOK; t0 += C.NGW * TP) {
        u32x2 wkv[TP], wsk[TP], wcq[TP], wsq[TP], wa[TP], wg[TP]; unsigned wcq2[TP];
#pragma unroll
        for (int i = 0; i < TP; ++i) { const int t = t0 + i; const bf16* pr = P + (size_t)t * INP; const bool full = !(last && t >= TL);
            wkv[i] = *((const u32x2*)pr + lane); wsk[i] = *((const u32x2*)(pr + O_SK) + lane);
            if (full) { wcq[i] = *((const u32x2*)(pr + O_CQ) + lane); wcq2[i] = *((const unsigned*)(pr + O_CQ + 256) + lane); wsq[i] = *((const u32x2*)(pr + O_SQ) + lane);
                wa[i] = *((const u32x2*)(pr + O_GLU) + lane); wg[i] = *((const u32x2*)(pr + O_GLU + 256) + lane); }
            else { wcq[i] = wsq[i] = wa[i] = wg[i] = (u32x2){0u, 0u}; wcq2[i] = 0u; } }
#pragma unroll
        for (int i = 0; i < TP; ++i) { const int t = t0 + i; int b, pos, key; bool isctx; tok_info(t, b, isctx, pos, key);
            {
                const u32x2 w = wkv[i]; f32x4 v = {bflo(w.x), bfhi(w.x), bflo(w.y), bfhi(w.y)};
                const float rstd = rsqrtf(wave_sum((v[0] * v[0] + v[1] * v[1]) + (v[2] * v[2] + v[3] * v[3])) * (1.f / 256.f) + EPS);
                v = v * rstd * gkv; u32x2 o; o.x = pk2(v[0], v[1]); o.y = pk2(v[2], v[3]); *((u32x2*)(CKVN + (size_t)t * 256) + lane) = o; }
            {
                const u32x2 w = wsk[i]; f32x4 v = {bflo(w.x), bfhi(w.x), bflo(w.y), bfhi(w.y)};
                const float ssh = grp16_sum((v[0] * v[0] + v[1] * v[1]) + (v[2] * v[2] + v[3] * v[3]));
                f32x4 kn = v * rsqrtf(ssh * (1.f / 64.f) + EPS) * gsk;
                const f32x4 kr = rope4(kn, ct, st, isctx ? 0 : pos, lane);
                if (!isctx) kn = kr;
                const int head = (lane >> 4) & 1; const size_t off = ((size_t)(b * 2 + head) * NKEY + key) * 64 + 4 * (lane & 15);
                u32x2 o; if (lane < 32) { o.x = pk2(kn[0], kn[1]); o.y = pk2(kn[2], kn[3]); *(u32x2*)(SK + off) = o; } else { *(u32x2*)(SV + off) = w; } }
            if (!(last && isctx)) {
                {
                    const u32x2 w = wcq[i]; const unsigned w2 = wcq2[i];
                    f32x4 v = {bflo(w.x), bfhi(w.x), bflo(w.y), bfhi(w.y)}; f32x2 v2 = {bflo(w2), bfhi(w2)};
                    const float ssq = wave_sum((v[0] * v[0] + v[1] * v[1]) + (v[2] * v[2] + v[3] * v[3]) + (v2[0] * v2[0] + v2[1] * v2[1]));
                    if (lane == 0) { *(f32x2*)(MQ + (size_t)t * 2) = (f32x2){ssq, 0.f}; } }
                {
                    const u32x2 w = wsq[i]; f32x4 v = {bflo(w.x), bfhi(w.x), bflo(w.y), bfhi(w.y)};
                    const float ssh = grp16_sum((v[0] * v[0] + v[1] * v[1]) + (v[2] * v[2] + v[3] * v[3]));
                    f32x4 qn = v * rsqrtf(ssh * (1.f / 64.f) + EPS) * gsq;
                    const f32x4 qr = rope4(qn, ct, st, isctx ? 0 : pos, lane);
                    if (!isctx) qn = qr;
                    const int head = lane >> 4;
                    const size_t off = isctx ? ((size_t)32 * SEQ * 64 + ((size_t)(b * 4 + head) * NCTX + pos) * 64) : (((size_t)(b * 4 + head) * SEQ + pos) * 64);
                    u32x2 o; o.x = pk2(qn[0], qn[1]); o.y = pk2(qn[2], qn[3]); *(u32x2*)(SQ + off + 4 * (lane & 15)) = o; }
                {
                    const u32x2 xa = wa[i], xg = wg[i];
                    const float u0 = bflo(xa.x) * sigmoidf_(bflo(xg.x)), u1 = bfhi(xa.x) * sigmoidf_(bfhi(xg.x)), u2 = bflo(xa.y) * sigmoidf_(bflo(xg.y)), u3 = bfhi(xa.y) * sigmoidf_(bfhi(xg.y));
                    u32x2 o; o.x = pk2(u0, u1); o.y = pk2(u2, u3); *((u32x2*)(U + (size_t)t * 256) + lane) = o; }
            } }
    }
}
__device__ __forceinline__ void post_phase(Ctx& C, int l) { post_phase_t<3>(C, l); }

template <int TP> __device__ __forceinline__ void finalqk_phase_t(Ctx& C, int l) {
    const bf16* P = WSP(bf16, WS_P); const bf16* KRAW = WSP(bf16, WS_KRAW); const bf16* QRAW = WSP(bf16, WS_QRAW); bf16* KM = WSP(bf16, WS_KMLA); bf16* QM = WSP(bf16, WS_QMLA);
    const float* ct = WSP(float, WS_ROPE); const float* st = ct + 2048 * 32;
    const float* khg = C.in[I_KHN] + l * 192; const float* qhg = C.in[I_QHN] + l * 192;
    const int lane = C.lane, h = lane >> 4, c = lane & 15; const bool last = (l == NLAYER - 1);
    const f32x4 kg0 = *(const f32x4*)(khg + 8 * c), kg1 = *(const f32x4*)(khg + 8 * c + 4), kgp = *(const f32x4*)(khg + 128 + 4 * c);
    const f32x4 qg0 = *(const f32x4*)(qhg + 8 * c), qg1 = *(const f32x4*)(qhg + 8 * c + 4), qgp = *(const f32x4*)(qhg + 128 + 4 * c);
    for (int t0 = C.gw * TP; t0 < NTOK; t0 += C.NGW * TP) {
        u32x4 kn[TP]; u32x2 kp[TP];
#pragma unroll
        for (int i = 0; i < TP; ++i) { const int t = t0 + i;
            kn[i] = *(const u32x4*)(KRAW + (size_t)t * 512 + h * 128 + 8 * c); kp[i] = *(const u32x2*)(P + (size_t)t * INP + O_KROPE + 4 * c); }
#pragma unroll
        for (int i = 0; i < TP; ++i) { const int t = t0 + i; int b, pos, key; bool isctx; tok_info(t, b, isctx, pos, key); const int rn = isctx ? 0 : pos;
            { f32x4 a0 = {bflo(kn[i].x), bfhi(kn[i].x), bflo(kn[i].y), bfhi(kn[i].y)}, a1 = {bflo(kn[i].z), bfhi(kn[i].z), bflo(kn[i].w), bfhi(kn[i].w)}, pe = {bflo(kp[i].x), bfhi(kp[i].x), bflo(kp[i].y), bfhi(kp[i].y)};
              const float ss = row16_sum(((a0[0] * a0[0] + a0[1] * a0[1]) + (a0[2] * a0[2] + a0[3] * a0[3])) + ((a1[0] * a1[0] + a1[1] * a1[1]) + (a1[2] * a1[2] + a1[3] * a1[3])) + ((pe[0] * pe[0] + pe[1] * pe[1]) + (pe[2] * pe[2] + pe[3] * pe[3])));
              const float rstd = rsqrtf(ss * (1.f / 192.f) + EPS);
              a0 = a0 * rstd * kg0; a1 = a1 * rstd * kg1; pe = pe * rstd * kgp;
              const f32x4 per = rope4(pe, ct, st, rn, lane); if (!isctx) pe = per;
              bf16* dst = KM + ((size_t)(b * 4 + h) * NKEY + key) * 192;
              u32x4 w; w.x = pk2(a0[0], a0[1]); w.y = pk2(a0[2], a0[3]); w.z = pk2(a1[0], a1[1]); w.w = pk2(a1[2], a1[3]); *(u32x4*)(dst + 8 * c) = w;
              u32x2 w2; w2.x = pk2(pe[0], pe[1]); w2.y = pk2(pe[2], pe[3]); *(u32x2*)(dst + 128 + 4 * c) = w2; }
        }
    }
}
__device__ __forceinline__ void finalqk_phase(Ctx& C, int l) { finalqk_phase_t<3>(C, l); }

template <int RR> __device__ __forceinline__ void conv_taps(float (&acc)[32], const float (&w)[31], const LAS bf16* ubp) {
    if constexpr (RR < 62) {
        const float u = __builtin_bit_cast(float, (unsigned)ubp[RR * 256] << 16);
        constexpr int o_lo = RR > 30 ? RR - 30 : 0, o_hi = RR < 31 ? RR : 31;
#pragma unroll
        for (int o = o_lo; o <= o_hi; ++o) acc[o] += u * w[RR - o];
        conv_taps<RR + 1>(acc, w, ubp);
    }
}
__device__ __forceinline__ void conv_unit(Ctx& C, int l, int tb  , int L  , int n0) {
    const bf16* U = WSP(bf16, WS_U); unsigned char* CAT = (unsigned char*)WSP(bf16, WS_CAT);
    const int lane = lane_id_now(), wave = C.wave, tid = wave * 64 + lane;
    LAS bf16* ub = (LAS bf16*)C.lds;
    LAS float* Y = (LAS float*)(C.lds + 49152);
    const int c = tid & 255, hf = tid >> 8;
    u32x4 stg[6];
#pragma unroll
    for (int k = 0; k < 6; ++k) { const int i = tid + k * NTHREADS, row = i >> 5, ch = i & 31, n = n0 - 15 + row;
        stg[k] = (u32x4){0u, 0u, 0u, 0u}; if (i < 94 * 32 && n >= 0 && n < L) stg[k] = *((const GAS u32x4*)(U + (size_t)(tb + n) * 256) + ch); }
    const float* cw = C.in[I_CONVW] + (size_t)l * 31 * 256 + c;
    float w[31];
#pragma unroll
    for (int j = 0; j < 31; ++j) w[j] = cw[j * 256];
    const float bias = C.in[I_CONVB][l * 256 + c];
#pragma unroll
    for (int k = 0; k < 6; ++k) { const int i = tid + k * NTHREADS; if (i < 94 * 32) *((LAS u32x4*)ub + i) = stg[k]; }
    __syncthreads();
    {
        float acc[32];
#pragma unroll
        for (int o = 0; o < 32; ++o) acc[o] = bias;
        conv_taps<0>(acc, w, ub + (32 * hf) * 256 + c);
#pragma unroll
        for (int o = 0; o < 32; ++o) Y[(32 * hf + o) * 256 + c] = acc[o];
    }
    __syncthreads();
    {
        const f32x4 g = *((const f32x4*)(C.in[I_LNG] + l * 256) + lane), bb = *((const f32x4*)(C.in[I_LNB] + l * 256) + lane);
#pragma unroll
        for (int i = 0; i < 8; ++i) { const int o = wave * 8 + i; f32x4 y = *((const LAS f32x4*)(Y + o * 256) + lane);
            const float mean = wave_sum((y[0] + y[1]) + (y[2] + y[3])) * (1.f / 256.f); y = y - mean;
            const float var = wave_sum((y[0] * y[0] + y[1] * y[1]) + (y[2] * y[2] + y[3] * y[3])) * (1.f / 256.f);
            y = y * rsqrtf(var + EPS) * g + bb;
            *((GAS unsigned*)(CAT + (size_t)(tb + n0 + o) * DM + 512) + lane) = pk4_f8(y[0] * sigmoidf_(y[0]), y[1] * sigmoidf_(y[1]), y[2] * sigmoidf_(y[2]), y[3] * sigmoidf_(y[3])); }
    }
    __syncthreads();
}

__device__ __forceinline__ void attn_phase(Ctx& C, int l) {
    const bf16* KM = WSP(bf16, WS_KMLA); const bf16* VM = WSP(bf16, WS_VMLA); const bf16* QRAW = WSP(bf16, WS_QRAW);
    const bf16* SK = WSP(bf16, WS_SK); const bf16* SV = WSP(bf16, WS_SV); const bf16* SQ = WSP(bf16, WS_SQ); unsigned char* CAT = (unsigned char*)WSP(bf16, WS_CAT);
    using MLA = att::Body<192, 128, false, false>; using SWA = att::Body<64, 64, true, true>; using SWAC = att::Body<64, 64, false, true>;
    static_assert(MLA::LDS_NEED <= RING_BYTES, "lds");
    const bool first = (l == 0);
    for (int u = C.vcu; u < 256; u += C.G) {
        const int bh = u >> 3, qb = u & 7, b = bh >> 2, h = bh & 3;
#ifndef DBG_REP_ATT
#define DBG_REP_ATT 0
#endif
        for (int rp = 0; rp < ((DBG_REP_ATT & 1) ? 2 : 1); ++rp)
#if !defined(ATT_PART) || (ATT_PART & 1)
        MLA::run(QRAW + (size_t)(b * SEQ + qb * 256) * 768 + h * 192, KM + (size_t)bh * NKEY * 192, VM + (size_t)bh * NKEY * 128, (bf16*)(CAT + (size_t)(b * SEQ + qb * 256) * DM + h * 128), NKEY / 64, 256, 0, 0, 0.f, C.lds, C.wave,
                 768, C.in[I_QHN] + l * 192, WSP(float, WS_ROPE), WSP(float, WS_ROPE) + 2048 * 32, qb * 256, true, WSP(float, WS_MQ) + (size_t)(b * SEQ + qb * 256) * 2);
#endif
#if !defined(ATT_PART) || (ATT_PART & 2)
        for (int rp = 0; rp < ((DBG_REP_ATT & 2) ? 2 : 1); ++rp)
        { const int q0 = qb * 256, lo = q0 - 128 < 0 ? 0 : q0 - 128, hiK = q0 + 384 > SEQ ? SEQ : q0 + 384; const int kvh = b * 2 + (h >> 1);
          SWA::run(SQ + ((size_t)bh * SEQ + q0) * 64, SK + (size_t)kvh * NKEY * 64, SV + (size_t)kvh * NKEY * 64, (bf16*)(CAT + (size_t)(b * SEQ + q0) * DM + 768 + h * 64), 4 + (hiK - lo) / 64, NCTX + lo, q0, lo, C.in[I_SINK][l * 4 + h], C.lds, C.wave); }
#endif
#if !defined(ATT_PART) || (ATT_PART & 4)
        for (int rp = 0; rp < ((DBG_REP_ATT & 4) ? 2 : 1); ++rp)
        conv_unit(C, l, (u >> 5) * SEQ, SEQ, (u & 31) * 64);
#endif
    }
#if !defined(ATT_PART) || (ATT_PART & 8)
    if (first) {
        for (int u = C.vcu; u < 32; u += C.G) {
            const int b = u >> 2, h = u & 3;
            MLA::run(QRAW + (size_t)(TL + b * NCTX) * 768 + h * 192, KM + (size_t)u * NKEY * 192, VM + (size_t)u * NKEY * 128, (bf16*)(CAT + (size_t)(TL + b * NCTX) * DM + h * 128), 4, 256, 0, 0, 0.f, C.lds, C.wave,
                     768, C.in[I_QHN] + l * 192, WSP(float, WS_ROPE), WSP(float, WS_ROPE) + 2048 * 32, 0, false, WSP(float, WS_MQ) + (size_t)(TL + b * NCTX) * 2);
            const int kvh = b * 2 + (h >> 1);
            SWAC::run(SQ + (size_t)32 * SEQ * 64 + (size_t)u * NCTX * 64, SK + (size_t)kvh * NKEY * 64, SV + (size_t)kvh * NKEY * 64, (bf16*)(CAT + (size_t)(TL + b * NCTX) * DM + 768 + h * 64), 4, 256, 0, 0, C.in[I_SINK][l * 4 + h], C.lds, C.wave);
            conv_unit(C, l, TL + (u >> 2) * NCTX, NCTX, (u & 3) * 64);
        }
    }
#endif
}

__device__ __forceinline__ void router_phase(Ctx& C, int l, bool shadow = false) {
    const float* ada = WSP(float, WS_ADA); bf16* HF = WSP(bf16, WS_H); float* RG = shadow ? (float*)(C.ws + WS_END + 4 * MiB) : WSP(float, WS_ROUTEG); int* LISTE = shadow ? (int*)(C.ws + WS_END) : WSP(int, WS_LISTE);
    unsigned* cntg = (unsigned*)(C.ws + WS_CTL) + CW_CNT + (l + (shadow ? 2 : 0)) * 32 * 64;
    const int ntok = (l == 0) ? NTOK : TL, per = ntok / 256;
    constexpr int TB = 16, HP = 1028;
    LAS float* hfl = (LAS float*)C.lds;
    LAS float* part = (LAS float*)(C.lds + 66048);
    LAS int* lcnt = (LAS int*)(C.lds + 66048 + 16384);
    LAS int* lbase = lcnt + 32;
    LAS int* lent = lcnt + 64;
    const int lane = C.lane, w = C.wave;
    const float* ng = C.in[I_N2G] + l * 1024;
    if (C.tid < 32) lcnt[C.tid] = 0;
    float wb0[32], wb1[32];
    { const float* rw = C.in[I_RW] + (size_t)l * 1024 * 32 + (size_t)(128 * w + 32 * (lane >> 4)) * 32 + (lane & 15);
#pragma unroll
      for (int i = 0; i < 32; ++i) { wb0[i] = rw[i * 32]; wb1[i] = rw[i * 32 + 16]; } }
    const float rbias = C.in[I_RB][l * 32 + (lane & 31)];
    __syncthreads();
    u32x2 vr[2][4];
#define RT_LOAD(BT) do { _Pragma("unroll") for (int s2 = 0; s2 < 2; ++s2) { const int ti_ = (BT) + w + 8 * s2, t_ = C.vcu * per + ti_; \
        const bf16* x_ = WSP(bf16, WS_XS) + (size_t)t_ * DM; \
        _Pragma("unroll") for (int j = 0; j < 4; ++j) vr[s2][j] = (ti_ < per) ? *((const GAS u32x2*)x_ + lane + 64 * j) : (u32x2){0u, 0u}; } } while (0)
    RT_LOAD(0);
    for (int bt = 0; bt < per; bt += TB) {
        {
            f32x4 v[2][4];
#pragma unroll
            for (int s2 = 0; s2 < 2; ++s2)
#pragma unroll
                for (int j = 0; j < 4; ++j) { const u32x2 w_ = vr[s2][j]; v[s2][j] = (f32x4){bflo(w_.x), bfhi(w_.x), bflo(w_.y), bfhi(w_.y)}; }
#pragma unroll
            for (int s2 = 0; s2 < 2; ++s2) { const int ti = bt + w + 8 * s2, t = C.vcu * per + ti; const int r = (t < TL) ? (t >> 11) : 8;
                float ss = 0.f;
#pragma unroll
                for (int j = 0; j < 4; ++j) ss += (v[s2][j][0] * v[s2][j][0] + v[s2][j][1] * v[s2][j][1]) + (v[s2][j][2] * v[s2][j][2] + v[s2][j][3] * v[s2][j][3]);
                const float rstd = rsqrtf(wave_sum(ss) * (1.f / DM) + EPS);
                const float* sh = ada + (size_t)(l * 9 + r) * 6144 + 3 * 1024; const float* sc = sh + 1024;
#pragma unroll
                for (int j = 0; j < 4; ++j) { const f32x4 g = *((const GAS f32x4*)ng + lane + 64 * j), a = *((const GAS f32x4*)sc + lane + 64 * j), sft = *((const GAS f32x4*)sh + lane + 64 * j);
                    const f32x4 h = v[s2][j] * rstd * g * (a + 1.f) + sft; u32x2 o; o.x = pk2(h[0], h[1]); o.y = pk2(h[2], h[3]);
                    if (ti < per) *((GAS unsigned*)(C.ws + WS_HF8 + (size_t)t * DM) + lane + 64 * j) = pk4_f8(h[0], h[1], h[2], h[3]); (void)o; (void)HF;
                    *((LAS f32x4*)(hfl + (w + 8 * s2) * HP) + lane + 64 * j) = h; } }
        }
        __syncthreads();
        if (bt + TB < per) RT_LOAD(bt + TB);
        {
            f32x4 a0 = {0.f, 0.f, 0.f, 0.f}, a1 = {0.f, 0.f, 0.f, 0.f};
            const LAS float* ap = hfl + (lane & 15) * HP + 128 * w + 32 * (lane >> 4);
#pragma unroll
            for (int c4 = 0; c4 < 2; ++c4) { f32x4 av[4];
#pragma unroll
                for (int k = 0; k < 4; ++k) av[k] = *((const LAS f32x4*)ap + c4 * 4 + k);
#pragma unroll
                for (int k = 0; k < 16; ++k) { const int i = c4 * 16 + k;
                    a0 = __builtin_amdgcn_mfma_f32_16x16x4f32(av[k >> 2][k & 3], wb0[i], a0, 0, 0, 0);
                    a1 = __builtin_amdgcn_mfma_f32_16x16x4f32(av[k >> 2][k & 3], wb1[i], a1, 0, 0, 0); } }
#pragma unroll
            for (int q = 0; q < 4; ++q) { const int tk = 4 * (lane >> 4) + q; part[(tk * 8 + w) * 32 + (lane & 15)] = a0[q]; part[(tk * 8 + w) * 32 + 16 + (lane & 15)] = a1[q]; }
        }
        __syncthreads();
#pragma unroll
        for (int s2 = 0; s2 < 2; ++s2) {
            const int tl = w + 8 * s2, ti = bt + tl, t = C.vcu * per + ti;
            float val = -INFINITY;
            if (lane < 32) { val = rbias;
#pragma unroll
                for (int p = 0; p < 8; ++p) val += part[(tl * 8 + p) * 32 + lane]; }
            float sv[4]; int se[4];
#pragma unroll
            for (int k = 0; k < 4; ++k) { const float m = wave_max(val); const unsigned long long mk = __ballot(val == m); const int idx = __ffsll((long long)mk) - 1; sv[k] = m; se[k] = idx; if (lane == idx) val = -INFINITY; }
            const float e1 = __expf(sv[1] - sv[0]), e2 = __expf(sv[2] - sv[0]), e3 = __expf(sv[3] - sv[0]); const float inv = 1.f / (1.f + e1 + e2 + e3);
            if (lane < 4 && ti < per) { const int ee = lane == 0 ? se[0] : lane == 1 ? se[1] : lane == 2 ? se[2] : se[3]; const float gg = (lane == 0 ? 1.f : lane == 1 ? e1 : lane == 2 ? e2 : e3) * inv;
                const int lp = __hip_atomic_fetch_add(&lcnt[ee], 1, __ATOMIC_RELAXED, __HIP_MEMORY_SCOPE_WORKGROUP); ((GAS float*)RG)[t * 4 + lane] = gg; lent[(ti * 4 + lane) * 2] = t * 4 + lane; lent[(ti * 4 + lane) * 2 + 1] = (ee << 16) | lp; }
        }
    }
#undef RT_LOAD
    __syncthreads();
    if (C.tid < 32) lbase[C.tid] = (int)__hip_atomic_fetch_add(cntg + C.tid * 64, (unsigned)lcnt[C.tid], __ATOMIC_RELAXED, __HIP_MEMORY_SCOPE_AGENT);
    __syncthreads();
    for (int i = C.tid; i < per * 4; i += NTHREADS) { const int tk = lent[i * 2], q = lent[i * 2 + 1], ee = q >> 16, lp = q & 0xffff; ((GAS int*)LISTE)[(size_t)ee * NTOK + lbase[ee] + lp] = tk; }
    __syncthreads();
}

struct DenseSched {
    const char* A; const char* Bt; int nM, nN, K, G, c;
    __device__ __forceinline__ bool next(int i, pg8::Unit& u) const {
        const int L = i * G + c; if (L >= nM * nN) return false;
        pg8::order_map(L, nM, nN, u.pm, u.pn); u.A = A + (size_t)u.pm * 256 * K * 2; u.B = Bt + (size_t)u.pn * 256 * K * 2; return true; }
    __device__ __forceinline__ unsigned row_off(const pg8::Unit&, int) const { return 0u; }
};
struct PitchSched {
    const char* A; const char* Bt; int nM, nN, K, G, c; unsigned pitch;
    __device__ __forceinline__ bool next(int i, pg8::Unit& u) const {
        const int L = i * G + c; if (L >= nM * nN) return false;
        pg8::order_map(L, nM, nN, u.pm, u.pn); u.A = A; u.B = Bt + (size_t)u.pn * 256 * K * 2; return true; }
    __device__ __forceinline__ unsigned row_off(const pg8::Unit& u, int r) const { return (unsigned)(u.pm * 256 + r) * pitch; }
};
struct MoeTab { const LAS int* cnt; const LAS int* bstart; const LAS int* blk_e; };
template <bool G1> struct MoeSched {
    const char* A; const char* W; const int* LISTE; MoeTab T; int NB, nN, G, c;
    __device__ __forceinline__ bool next(int i, pg8::Unit& u) const {
        const int L = i * G + c; if (L >= NB * nN) return false;
        pg8::order_map(L, NB, nN, u.pm, u.pn); const int e = __builtin_amdgcn_readfirstlane(T.blk_e[u.pm]);
        u.A = A; u.B = W + ((size_t)e * nN + u.pn) * 256 * 1024; return true; }
    __device__ __forceinline__ unsigned row_off(const pg8::Unit& u, int r) const {
        if (!G1) return (unsigned)(u.pm * 256 + r) * 1024u;
        const int e = __builtin_amdgcn_readfirstlane(T.blk_e[u.pm]), pos = (u.pm - __builtin_amdgcn_readfirstlane(T.bstart[e])) * 256 + r, cn = __builtin_amdgcn_readfirstlane(T.cnt[e]);
        const int tk = ((const GAS int*)LISTE)[(size_t)e * NTOK + (pos < cn ? pos : 0)]; return (unsigned)(tk >> 2) * (G1 ? 1024u : 2048u); }
};
typedef const f32x4 (&AccRef)[2][2][4][2];
struct EpiStoreBf16 { static constexpr bool INIT = false; struct PreT {}; static constexpr bool PERM = true; bf16* O; int ldc;
    __device__ __forceinline__ void operator()(AccRef acc, const pg8::Unit& u, int wr, int wc, int fr, int fq) const {
        const int row0 = u.pm * 256 + wr * 64 + fr, col0 = u.pn * 256 + wc * 32 + 8 * fq;
#pragma unroll
        for (int ai = 0; ai < 2; ++ai)
#pragma unroll
            for (int m = 0; m < 4; ++m) { bf16* rowp = O + (size_t)(row0 + ai * 128 + m * 16) * ldc + col0;
#pragma unroll
                for (int bj = 0; bj < 2; ++bj) { const f32x4 v0 = acc[ai][bj][m][0], v1 = acc[ai][bj][m][1];
                    u32x4 w; w.x = cvt_pk_bf16(v0[0], v0[1]); w.y = cvt_pk_bf16(v0[2], v0[3]); w.z = cvt_pk_bf16(v1[0], v1[1]); w.w = cvt_pk_bf16(v1[2], v1[3]); *(GAS u32x4*)(rowp + bj * 128) = w; } }
    } };
struct EpiKvUp { static constexpr bool INIT = false; struct PreT {}; static constexpr bool PERM = true; bf16* KRAW; bf16* VM;
    __device__ __forceinline__ void operator()(AccRef acc, const pg8::Unit& u, int wr, int wc, int fr, int fq) const {
        const int t0 = u.pm * 256, h = u.pn; const bool isctx = t0 >= TL;
        const int b = isctx ? (t0 - TL) >> 8 : t0 >> 11, key0 = isctx ? 0 : NCTX + (t0 & 2047);
        const int rin = wr * 64 + fr, c0 = wc * 32 + 8 * fq;
        bf16* kr = KRAW + (size_t)t0 * 512 + h * 128 + c0; bf16* vr = VM + ((size_t)(b * 4 + h) * NKEY + key0) * 128 + c0;
#pragma unroll
        for (int ai = 0; ai < 2; ++ai)
#pragma unroll
            for (int m = 0; m < 4; ++m) { const int rr = rin + ai * 128 + m * 16;
                { const f32x4 v0 = acc[ai][0][m][0], v1 = acc[ai][0][m][1]; u32x4 w; w.x = cvt_pk_bf16(v0[0], v0[1]); w.y = cvt_pk_bf16(v0[2], v0[3]); w.z = cvt_pk_bf16(v1[0], v1[1]); w.w = cvt_pk_bf16(v1[2], v1[3]);
                  *(GAS u32x4*)(kr + (size_t)rr * 512) = w; }
                { const f32x4 v0 = acc[ai][1][m][0], v1 = acc[ai][1][m][1]; u32x4 w; w.x = cvt_pk_bf16(v0[0], v0[1]); w.y = cvt_pk_bf16(v0[2], v0[3]); w.z = cvt_pk_bf16(v1[0], v1[1]); w.w = cvt_pk_bf16(v1[2], v1[3]);
                  *(GAS u32x4*)(vr + (size_t)rr * 128) = w; } }
    } };
struct EpiWin { static constexpr bool INIT = false; struct PreT {}; static constexpr bool PERM = true; bf16* P; bf16* CKVN; float* MQ; bf16* SK; bf16* SV; bf16* SQ; bf16* U; const float* gkv; const float* gsk; const float* gsq; const float* ct; const float* st; LAS float* part;
    __device__ __forceinline__ void operator()(AccRef acc, const pg8::Unit& u, int wr, int wc, int fr, int fq) const {
        const int t0 = u.pm * 256, pn = u.pn; const bool isctx = t0 >= TL;
        const int b = isctx ? (t0 - TL) >> 8 : t0 >> 11, key0 = isctx ? 0 : NCTX + (t0 & 2047), pos0 = isctx ? 0 : (t0 & 2047);
        const int rin = wr * 64 + fr, c0 = wc * 32 + 8 * fq;
        if (pn >= 5) {
            bf16* up = U + (size_t)t0 * 256 + (pn - 5) * 128 + c0;
#pragma unroll
            for (int ai = 0; ai < 2; ++ai)
#pragma unroll
                for (int m = 0; m < 4; ++m) { const int rw = rin + ai * 128 + m * 16; float o[8];
#pragma unroll
                    for (int e = 0; e < 8; ++e) o[e] = acc[ai][0][m][e >> 2][e & 3] * sigmoidf_(acc[ai][1][m][e >> 2][e & 3]);
                    u32x4 w; w.x = cvt_pk_bf16(o[0], o[1]); w.y = cvt_pk_bf16(o[2], o[3]); w.z = cvt_pk_bf16(o[4], o[5]); w.w = cvt_pk_bf16(o[6], o[7]);
                    *(GAS u32x4*)(up + (size_t)rw * 256) = w; }
            return;
        }
#pragma unroll
        for (int ai = 0; ai < 2; ++ai)
#pragma unroll
            for (int m = 0; m < 4; ++m)
#pragma unroll
                for (int bj = 0; bj < 2; ++bj) { const f32x4 v0 = acc[ai][bj][m][0], v1 = acc[ai][bj][m][1];
                    float q = ((v0[0] * v0[0] + v0[1] * v0[1]) + (v0[2] * v0[2] + v0[3] * v0[3])) + ((v1[0] * v1[0] + v1[1] * v1[1]) + (v1[2] * v1[2] + v1[3] * v1[3]));
                    q += swz_xor<16>(q); q += xhalf(q);
                    if (fq == 0) part[(rin + ai * 128 + m * 16) * 8 + bj * 4 + wc] = q; }
        asm volatile("s_waitcnt lgkmcnt(0)\n\ts_barrier" ::: "memory");
        if (pn == 0) {
            f32x4 g[2][2];
#pragma unroll
            for (int bj = 0; bj < 2; ++bj)
#pragma unroll
                for (int n = 0; n < 2; ++n) g[bj][n] = *(const GAS f32x4*)(gkv + c0 + bj * 128 + n * 4);
#pragma unroll
            for (int ai = 0; ai < 2; ++ai)
#pragma unroll
                for (int m = 0; m < 4; ++m) { const int rw = rin + ai * 128 + m * 16;
                    const f32x4 pa = *(const LAS f32x4*)(part + rw * 8), pb = *(const LAS f32x4*)(part + rw * 8 + 4);
                    const float rstd = rsqrtf((((pa[0] + pa[1]) + (pa[2] + pa[3])) + ((pb[0] + pb[1]) + (pb[2] + pb[3]))) * (1.f / 256.f) + EPS);
                    bf16* rowp = CKVN + (size_t)(t0 + rw) * 256 + c0;
#pragma unroll
                    for (int bj = 0; bj < 2; ++bj) { const f32x4 v0 = acc[ai][bj][m][0] * rstd * g[bj][0], v1 = acc[ai][bj][m][1] * rstd * g[bj][1];
                        u32x4 w; w.x = cvt_pk_bf16(v0[0], v0[1]); w.y = cvt_pk_bf16(v0[2], v0[3]); w.z = cvt_pk_bf16(v1[0], v1[1]); w.w = cvt_pk_bf16(v1[2], v1[3]); *(GAS u32x4*)(rowp + bj * 128) = w; } }
        } else if (pn <= 2) {
            { const int tid = (wr * 4 + wc) * 64 + fq * 16 + fr;
              if (tid < 256) { const f32x4 pa = *(const LAS f32x4*)(part + tid * 8), pb = *(const LAS f32x4*)(part + tid * 8 + 4);
                  const float s0 = (pa[0] + pa[1]) + (pa[2] + pa[3]), s1 = (pb[0] + pb[1]) + (pb[2] + pb[3]);
                  MQ[(size_t)(t0 + tid) * 2 + (pn - 1)] = (pn == 1) ? s0 + s1 : s0; } }
#pragma unroll
            for (int ai = 0; ai < 2; ++ai)
#pragma unroll
                for (int m = 0; m < 4; ++m) { bf16* rowp = P + (size_t)(t0 + rin + ai * 128 + m * 16) * INP + pn * 256 + c0;
#pragma unroll
                    for (int bj = 0; bj < 2; ++bj) { const f32x4 v0 = acc[ai][bj][m][0], v1 = acc[ai][bj][m][1];
                        u32x4 w; w.x = cvt_pk_bf16(v0[0], v0[1]); w.y = cvt_pk_bf16(v0[2], v0[3]); w.z = cvt_pk_bf16(v1[0], v1[1]); w.w = cvt_pk_bf16(v1[2], v1[3]); *(GAS u32x4*)(rowp + bj * 128) = w; } }
        } else {
            const int hd = wc >> 1, d0 = (wc & 1) * 32 + 8 * fq; const bool x2lane = fq >= 2;
            const float* gp = (pn == 3 ? gsk : gsq) + d0; const f32x4 g0 = *(const GAS f32x4*)gp, g1 = *(const GAS f32x4*)(gp + 4);
            const int tabo = (wc & 1) * 16 + 8 * (fq & 1);
#pragma unroll
            for (int ai = 0; ai < 2; ++ai)
#pragma unroll
                for (int m = 0; m < 4; ++m) { const int rw = rin + ai * 128 + m * 16;
                    const f32x4 pa = *(const LAS f32x4*)(part + rw * 8), pb = *(const LAS f32x4*)(part + rw * 8 + 4);
                    f32x4 cv0, cv1, sv0, sv1;
                    if (!isctx) { const float* cp = ct + (size_t)(pos0 + rw) * 32 + tabo; const float* sp = st + (size_t)(pos0 + rw) * 32 + tabo;
                        cv0 = *(const GAS f32x4*)cp; cv1 = *(const GAS f32x4*)(cp + 4); sv0 = *(const GAS f32x4*)sp; sv1 = *(const GAS f32x4*)(sp + 4); }
                    else { cv0 = cv1 = (f32x4){1.f, 1.f, 1.f, 1.f}; sv0 = sv1 = (f32x4){0.f, 0.f, 0.f, 0.f}; }
#pragma unroll
                    for (int bj = 0; bj < 2; ++bj) {
                        if (pn == 3 && bj == 1) {
                            const f32x4 v0 = acc[ai][1][m][0], v1 = acc[ai][1][m][1]; u32x4 w; w.x = cvt_pk_bf16(v0[0], v0[1]); w.y = cvt_pk_bf16(v0[2], v0[3]); w.z = cvt_pk_bf16(v1[0], v1[1]); w.w = cvt_pk_bf16(v1[2], v1[3]);
                            *(GAS u32x4*)(SV + ((size_t)(b * 2 + hd) * NKEY + key0 + rw) * 64 + d0) = w;
                        } else {
                            const f32x4 pp = bj ? pb : pa; const float ssh = hd ? (pp[2] + pp[3]) : (pp[0] + pp[1]);
                            const float rstd = rsqrtf(ssh * (1.f / 64.f) + EPS);
                            const f32x4 n0 = acc[ai][bj][m][0] * rstd * g0, n1 = acc[ai][bj][m][1] * rstd * g1;
                            float o[8];
#pragma unroll
                            for (int e = 0; e < 8; ++e) { const float nv = e < 4 ? n0[e] : n1[e - 4], pv = xhalf(nv), cc = e < 4 ? cv0[e] : cv1[e - 4], sn = e < 4 ? sv0[e] : sv1[e - 4];
                                o[e] = x2lane ? (pv * sn + nv * cc) : (nv * cc - pv * sn); }
                            u32x4 w; w.x = cvt_pk_bf16(o[0], o[1]); w.y = cvt_pk_bf16(o[2], o[3]); w.z = cvt_pk_bf16(o[4], o[5]); w.w = cvt_pk_bf16(o[6], o[7]);
                            if (pn == 3) *(GAS u32x4*)(SK + ((size_t)(b * 2 + hd) * NKEY + key0 + rw) * 64 + d0) = w;
                            else { const int h4 = bj * 2 + hd; bf16* dst = isctx ? SQ + (size_t)32 * SEQ * 64 + ((size_t)(b * 4 + h4) * NCTX + rw) * 64 : SQ + ((size_t)(b * 4 + h4) * SEQ + pos0 + rw) * 64;
                                *(GAS u32x4*)(dst + d0) = w; } } } }
        }
    } };
struct EpiKvUpN { static constexpr bool INIT = false; struct PreT {}; static constexpr bool PERM = true; bf16* KM; bf16* VM; const bf16* P; const float* khg; const float* ct; const float* st; LAS float* part;
    __device__ __forceinline__ void operator()(AccRef acc, const pg8::Unit& u, int wr, int wc, int fr, int fq) const {
        const int t0 = u.pm * 256, h = u.pn; const bool isctx = t0 >= TL;
        const int b = isctx ? (t0 - TL) >> 8 : t0 >> 11, key0 = isctx ? 0 : NCTX + (t0 & 2047), pos0 = isctx ? 0 : (t0 & 2047);
        const int rin = wr * 64 + fr, c0 = wc * 32 + 8 * fq;
        const int tid = (wr * 4 + wc) * 64 + fq * 16 + fr, rr = tid >> 1, ax = tid & 1;
        const bf16* kp = P + (size_t)(t0 + rr) * INP + NP_KROPE + ax * 32;
        u32x4 kw[4];
#pragma unroll
        for (int i = 0; i < 4; ++i) kw[i] = *(const GAS u32x4*)(kp + i * 8);
#pragma unroll
        for (int ai = 0; ai < 2; ++ai)
#pragma unroll
            for (int m = 0; m < 4; ++m) { const f32x4 v0 = acc[ai][0][m][0], v1 = acc[ai][0][m][1];
                float q = ((v0[0] * v0[0] + v0[1] * v0[1]) + (v0[2] * v0[2] + v0[3] * v0[3])) + ((v1[0] * v1[0] + v1[1] * v1[1]) + (v1[2] * v1[2] + v1[3] * v1[3]));
                q += swz_xor<16>(q); q += xhalf(q);
                if (fq == 0) part[(rin + ai * 128 + m * 16) * 8 + wc] = q; }
        { float ks = 0.f;
#pragma unroll
          for (int i = 0; i < 4; ++i)
#pragma unroll
              for (int w = 0; w < 4; ++w) { const float a = bflo(kw[i][w]), c = bfhi(kw[i][w]); ks += a * a + c * c; }
          part[rr * 8 + 4 + ax] = ks; }
        asm volatile("s_waitcnt lgkmcnt(0)\n\ts_barrier" ::: "memory");
        const f32x4 g0 = *(const GAS f32x4*)(khg + c0), g1 = *(const GAS f32x4*)(khg + c0 + 4);
        bf16* kr = KM + ((size_t)(b * 4 + h) * NKEY + key0) * 192 + c0; bf16* vr = VM + ((size_t)(b * 4 + h) * NKEY + key0) * 128 + c0;
#pragma unroll
        for (int ai = 0; ai < 2; ++ai)
#pragma unroll
            for (int m = 0; m < 4; ++m) { const int rw = rin + ai * 128 + m * 16;
                const f32x4 pa = *(const LAS f32x4*)(part + rw * 8); const f32x2 pb = *(const LAS f32x2*)(part + rw * 8 + 4);
                const float rstd = rsqrtf((((pa[0] + pa[1]) + (pa[2] + pa[3])) + (pb[0] + pb[1])) * (1.f / 192.f) + EPS);
                { const f32x4 v0 = acc[ai][0][m][0] * rstd * g0, v1 = acc[ai][0][m][1] * rstd * g1; u32x4 w; w.x = cvt_pk_bf16(v0[0], v0[1]); w.y = cvt_pk_bf16(v0[2], v0[3]); w.z = cvt_pk_bf16(v1[0], v1[1]); w.w = cvt_pk_bf16(v1[2], v1[3]);
                  *(GAS u32x4*)(kr + (size_t)rw * 192) = w; }
                { const f32x4 v0 = acc[ai][1][m][0], v1 = acc[ai][1][m][1]; u32x4 w; w.x = cvt_pk_bf16(v0[0], v0[1]); w.y = cvt_pk_bf16(v0[2], v0[3]); w.z = cvt_pk_bf16(v1[0], v1[1]); w.w = cvt_pk_bf16(v1[2], v1[3]);
                  *(GAS u32x4*)(vr + (size_t)rw * 128) = w; } }
        {
          const f32x4 pa = *(const LAS f32x4*)(part + rr * 8); const f32x2 pb = *(const LAS f32x2*)(part + rr * 8 + 4);
          const float rstd = rsqrtf((((pa[0] + pa[1]) + (pa[2] + pa[3])) + (pb[0] + pb[1])) * (1.f / 192.f) + EPS);
          const float* gp = khg + 128 + ax * 32; const float* cp = ct + (size_t)(pos0 + rr) * 32 + ax * 16; const float* sp = st + (size_t)(pos0 + rr) * 32 + ax * 16;
          bf16* dst = KM + ((size_t)(b * 4 + h) * NKEY + key0 + rr) * 192 + 128 + ax * 32;
#pragma unroll
          for (int i = 0; i < 2; ++i) {
              const f32x4 ga0 = *(const GAS f32x4*)(gp + 8 * i), ga1 = *(const GAS f32x4*)(gp + 8 * i + 4), gb0 = *(const GAS f32x4*)(gp + 16 + 8 * i), gb1 = *(const GAS f32x4*)(gp + 16 + 8 * i + 4);
              float x1[8], x2[8];
#pragma unroll
              for (int w = 0; w < 4; ++w) { x1[2 * w] = bflo(kw[i][w]) * rstd * (w < 2 ? ga0[2 * w] : ga1[2 * w - 4]); x1[2 * w + 1] = bfhi(kw[i][w]) * rstd * (w < 2 ? ga0[2 * w + 1] : ga1[2 * w - 3]);
                  x2[2 * w] = bflo(kw[2 + i][w]) * rstd * (w < 2 ? gb0[2 * w] : gb1[2 * w - 4]); x2[2 * w + 1] = bfhi(kw[2 + i][w]) * rstd * (w < 2 ? gb0[2 * w + 1] : gb1[2 * w - 3]); }
              if (!isctx) { const f32x4 c0v = *(const GAS f32x4*)(cp + 8 * i), c1v = *(const GAS f32x4*)(cp + 8 * i + 4), s0v = *(const GAS f32x4*)(sp + 8 * i), s1v = *(const GAS f32x4*)(sp + 8 * i + 4);
#pragma unroll
                  for (int e = 0; e < 8; ++e) { const float cc = e < 4 ? c0v[e] : c1v[e - 4], sn = e < 4 ? s0v[e] : s1v[e - 4]; const float y1 = x1[e], y2 = x2[e]; x1[e] = y1 * cc - y2 * sn; x2[e] = y1 * sn + y2 * cc; } }
              u32x4 w1, w2; w1.x = cvt_pk_bf16(x1[0], x1[1]); w1.y = cvt_pk_bf16(x1[2], x1[3]); w1.z = cvt_pk_bf16(x1[4], x1[5]); w1.w = cvt_pk_bf16(x1[6], x1[7]);
              w2.x = cvt_pk_bf16(x2[0], x2[1]); w2.y = cvt_pk_bf16(x2[2], x2[3]); w2.z = cvt_pk_bf16(x2[4], x2[5]); w2.w = cvt_pk_bf16(x2[6], x2[7]);
              *(GAS u32x4*)(dst + 8 * i) = w1; *(GAS u32x4*)(dst + 16 + 8 * i) = w2; } }
    } };
struct EpiOutRes { static constexpr bool INIT = false; struct PreT {}; struct CarryT {}; static constexpr bool PERM = true; const float* xl_in; const float* xc_in; const bf16* xs_in; bf16* xs_out; const float* ada_l; bool first;
    __device__ __forceinline__ void operator()(AccRef acc, const pg8::Unit& u, int wr, int wc, int fr, int fq) const {
        const int t0 = u.pm * 256; const bool isctx = t0 >= TL; const int r = isctx ? 8 : (t0 >> 11);
        const float* g1 = ada_l + (size_t)r * 6144 + 2 * 1024;
        const int row0 = t0 + wr * 64 + fr, col0 = u.pn * 256 + wc * 32 + 8 * fq;
        f32x4 gv[2][2];
#pragma unroll
        for (int bj = 0; bj < 2; ++bj)
#pragma unroll
            for (int n = 0; n < 2; ++n) gv[bj][n] = *(const GAS f32x4*)(g1 + col0 + bj * 128 + n * 4);
#pragma unroll
        for (int ai = 0; ai < 2; ++ai)
#pragma unroll
            for (int m = 0; m < 4; ++m) { const int row = row0 + ai * 128 + m * 16;
#pragma unroll
                for (int bj = 0; bj < 2; ++bj) { f32x4 x0, x1;
                    if (first) { const float* xp = (isctx ? xc_in + (size_t)(row - TL) * DM : xl_in + (size_t)row * DM) + col0 + bj * 128; x0 = *(const GAS f32x4*)xp; x1 = *(const GAS f32x4*)(xp + 4); }
                    else { const u32x4 w = *(const GAS u32x4*)(xs_in + (size_t)row * DM + col0 + bj * 128); x0 = (f32x4){bflo(w.x), bfhi(w.x), bflo(w.y), bfhi(w.y)}; x1 = (f32x4){bflo(w.z), bfhi(w.z), bflo(w.w), bfhi(w.w)}; }
                    const f32x4 y0 = x0 + gv[bj][0] * acc[ai][bj][m][0], y1 = x1 + gv[bj][1] * acc[ai][bj][m][1];
                    u32x4 o; o.x = cvt_pk_bf16(y0[0], y0[1]); o.y = cvt_pk_bf16(y0[2], y0[3]); o.z = cvt_pk_bf16(y1[0], y1[1]); o.w = cvt_pk_bf16(y1[2], y1[3]);
                    *(GAS u32x4*)(xs_out + (size_t)row * DM + col0 + bj * 128) = o; } }
    } };
struct EpiMoe1 { static constexpr bool INIT = true; static constexpr bool PERM = true; bf16* ACT; const float* b1; MoeTab T;
    struct PreT { f32x4 q[4]; };
    typedef f32x4 (&AccW)[2][2][4][2];
    __device__ __forceinline__ PreT pre(const pg8::Unit& u, int wr, int wc, int fr, int fq) const {
        const int e = __builtin_amdgcn_readfirstlane(T.blk_e[u.pm]); const int j0 = u.pn * 128 + wc * 32 + 8 * fq;
        const float* bp = b1 + (size_t)e * 2048 + 2 * j0; PreT p;
#pragma unroll
        for (int i = 0; i < 4; ++i) p.q[i] = *(const GAS f32x4*)(bp + 4 * i);
        return p; }
    __device__ __forceinline__ void init(AccW acc, const PreT& p) const {
        const f32x4 g0 = {p.q[0][0], p.q[0][2], p.q[1][0], p.q[1][2]}, g1 = {p.q[2][0], p.q[2][2], p.q[3][0], p.q[3][2]};
        const f32x4 l0 = {p.q[0][1], p.q[0][3], p.q[1][1], p.q[1][3]}, l1 = {p.q[2][1], p.q[2][3], p.q[3][1], p.q[3][3]};
#pragma unroll
        for (int a = 0; a < 2; ++a)
#pragma unroll
            for (int m = 0; m < 4; ++m) { acc[a][0][m][0] = g0; acc[a][0][m][1] = g1; acc[a][1][m][0] = l0; acc[a][1][m][1] = l1; } }
    __device__ __forceinline__ void operator()(AccRef acc, const pg8::Unit& u, int wr, int wc, int fr, int fq) const {
        const int j0 = u.pn * 128 + wc * 32 + 8 * fq;
        const int row0 = u.pm * 256 + wr * 64 + fr;
#pragma unroll
        for (int ai = 0; ai < 2; ++ai)
#pragma unroll
            for (int m = 0; m < 4; ++m) { float a[8];
#pragma unroll
                for (int i = 0; i < 8; ++i) { const float ug = acc[ai][0][m][i >> 2][i & 3], ul = acc[ai][1][m][i >> 2][i & 3];
                    const float xg = fminf(ug, 7.f), xl = fminf(fmaxf(ul, -7.f), 7.f);
                    a[i] = xg * __builtin_amdgcn_rcpf(1.f + __builtin_amdgcn_exp2f(xg * (-1.702f * 1.4426950408889634f))) * (xl + 1.f); }
                u32x2 w; w.x = pk4_f8(a[0], a[1], a[2], a[3]); w.y = pk4_f8(a[4], a[5], a[6], a[7]);
                *(GAS u32x2*)((unsigned char*)ACT + (size_t)(row0 + ai * 128 + m * 16) * 1024 + j0) = w; }
    } };
struct EpiMoe2 { static constexpr bool INIT = true; static constexpr bool PERM = true; bf16* YK; const float* b2; const float* RG; const int* LISTE; MoeTab T;
    struct PreT { f32x4 bv[2][2]; };
    typedef f32x4 (&AccW)[2][2][4][2];
    __device__ __forceinline__ PreT pre(const pg8::Unit& u, int wr, int wc, int fr, int fq) const {
        const int e = __builtin_amdgcn_readfirstlane(T.blk_e[u.pm]); const int col0 = u.pn * 256 + wc * 32 + 8 * fq; PreT p;
#pragma unroll
        for (int bj = 0; bj < 2; ++bj)
#pragma unroll
            for (int n = 0; n < 2; ++n) p.bv[bj][n] = *(const GAS f32x4*)(b2 + (size_t)e * 1024 + col0 + bj * 128 + 4 * n);
        return p; }
    __device__ __forceinline__ void init(AccW acc, const PreT& p) const {
#pragma unroll
        for (int a = 0; a < 2; ++a)
#pragma unroll
            for (int bj = 0; bj < 2; ++bj)
#pragma unroll
                for (int m = 0; m < 4; ++m) { acc[a][bj][m][0] = p.bv[bj][0]; acc[a][bj][m][1] = p.bv[bj][1]; } }
    __device__ __forceinline__ void operator()(AccRef acc, const pg8::Unit& u, int wr, int wc, int fr, int fq) const {
        const int e = __builtin_amdgcn_readfirstlane(T.blk_e[u.pm]), pos0 = (u.pm - __builtin_amdgcn_readfirstlane(T.bstart[e])) * 256, cn = __builtin_amdgcn_readfirstlane(T.cnt[e]);
        const int col0 = u.pn * 256 + wc * 32 + 8 * fq;
        int tkv[8]; float gv[8];
#pragma unroll
        for (int q = 0; q < 8; ++q) { const int pos = pos0 + wr * 64 + fr + (q >> 2) * 128 + (q & 3) * 16; tkv[q] = (pos < cn) ? ((const GAS int*)LISTE)[(size_t)e * NTOK + pos] : -1; }
#pragma unroll
        for (int q = 0; q < 8; ++q) gv[q] = (tkv[q] >= 0) ? ((const GAS float*)RG)[tkv[q]] : 0.f;
#pragma unroll
        for (int ai = 0; ai < 2; ++ai)
#pragma unroll
            for (int m = 0; m < 4; ++m) { const int tk = tkv[ai * 4 + m]; const float g = gv[ai * 4 + m];
                if (tk >= 0) { unsigned char* rowp = (unsigned char*)YK + (size_t)tk * 1024 + col0; const float g32 = g * YK_SCALE;
#pragma unroll
                    for (int bj = 0; bj < 2; ++bj) { const f32x4 v0 = acc[ai][bj][m][0] * g32, v1 = acc[ai][bj][m][1] * g32;
                        u32x2 w; w.x = pk4_f8(v0[0], v0[1], v0[2], v0[3]); w.y = pk4_f8(v1[0], v1[1], v1[2], v1[3]); *(GAS u32x2*)(rowp + bj * 128) = w; } } }
    } };

__device__ __forceinline__ int moe_tables(Ctx& C, int l) {
    LAS int* cnt = (LAS int*)(C.lds + TAB_OFF); LAS int* bstart = cnt + 32; LAS int* blk_e = bstart + 36; LAS int* nbp = blk_e + MAXBLK;
    const unsigned* cntg = (const unsigned*)(C.ws + WS_CTL) + CW_CNT + l * 32 * 64;
    __syncthreads();
    if (C.tid < 32) cnt[C.tid] = (int)__hip_atomic_load(cntg + C.tid * 64, __ATOMIC_RELAXED, __HIP_MEMORY_SCOPE_AGENT);
    __syncthreads();
    if (C.tid < 32) { const int e = C.tid; int st = 0, tot = 0;
#pragma nounroll
        for (int j = 0; j < 32; ++j) { const int nb = (cnt[j] + 255) >> 8; st += (j < e) ? nb : 0; tot += nb; }
        bstart[e] = st; if (e == 0) { bstart[32] = tot; nbp[0] = tot; }
        const int nbe = (cnt[e] + 255) >> 8;
#pragma clang loop vectorize(disable) unroll(disable)
        for (int b = 0; b < nbe; ++b) blk_e[st + b] = e; }
    __syncthreads();
    return __builtin_amdgcn_readfirstlane(nbp[0]);
}

__device__ __forceinline__ void fresh_lane(Ctx& C) { const int ln = lane_id_now(); C.lane = ln; C.tid = C.wave * 64 + ln; C.gw = C.vcu * NWAVES + C.wave; }
__device__ __forceinline__ void fresh_ids(Ctx& C, unsigned char* ws) {
    asm volatile("" : "+s"(ws)); C.ws = ws;
    KArgs kp = (KArgs)__builtin_amdgcn_kernarg_segment_ptr(); asm volatile("" : "+s"(kp)); C.in = kp;
}
constexpr int PH_PER_LAYER = 8, N_PHASES = 1 + NLAYER * PH_PER_LAYER + 1;
__global__ void __launch_bounds__(NTHREADS, 2) mk_fwd(Args args) {
    extern __shared__ __attribute__((aligned(16))) unsigned char lds_raw[];
    Ctx C;
    C.lds = (LAS unsigned char*)lds_raw; C.ldsg = (char*)lds_raw;
    C.wave = __builtin_amdgcn_readfirstlane(threadIdx.x >> 6); C.lane = lane_id_now(); C.tid = C.wave * 64 + C.lane;
    C.G = gridDim.x; { const int bx = blockIdx.x; C.vcu = (C.G % 8 == 0) ? (bx % 8) * (C.G / 8) + bx / 8 : bx; }
    C.gw = C.vcu * NWAVES + C.wave; C.NGW = C.G * NWAVES;
    C.ws = args.ws; C.in = (KArgs)__builtin_amdgcn_kernarg_segment_ptr(); C.out = args.out;
    volatile LAS unsigned* MISC = (volatile LAS unsigned*)(C.lds + MISC_OFF);
    for (int u = C.tid; u < (LDS_BYTES - LDSCTL_OFF) / 4; u += NTHREADS) ((LAS unsigned*)(C.lds + LDSCTL_OFF))[u] = 0u;
    __syncthreads();
    const int lo = args.ph_lo, hi = args.ph_hi;
    const bool multi = (hi - lo) > 1;
    XcdBarrier bar; bar.bar = (unsigned*)(C.ws + WS_CTL) + CW_BAR; bar.x = 0; bar.st = nullptr;
    if (multi) bar = xcd_barrier_post((unsigned*)(C.ws + WS_CTL) + CW_BAR, MISC + 8, C.tid);
#ifdef PH_ONLY
#define PHK(kind) ((kind) == PH_ONLY)
#else
#define PHK(kind) true
#endif
    for (int ph = lo; ph < hi; ++ph) {
        fresh_ids(C, args.ws);
        int kind, l;
        if (ph == 0) { kind = 0; l = 0; } else if (ph == N_PHASES - 1) { kind = 11; l = NLAYER - 1; } else { l = (ph - 1) / PH_PER_LAYER; const int k = (ph - 1) % PH_PER_LAYER; kind = k < 2 ? k + 1 : k == 2 ? 4 : k + 3; }
        unsigned char* wb = C.ws + WS_W + (size_t)l * WB_LAYER;
        const bool last = (l == NLAYER - 1);
        const float* ada_l = WSP(float, WS_ADA) + (size_t)l * 9 * 6144;
#ifndef DBG_REPEAT_KIND
#define DBG_REPEAT_KIND -1
#endif
        const int reps = (kind == DBG_REPEAT_KIND && (l == 0 || (kind != 1 && kind != 7))) ? 2 : 1;
        for (int rep = 0; rep < reps; ++rep) {
        if (rep > 0) { fresh_lane(C); xcd_barrier(bar, C.tid); }
        switch (kind) {
        case 0: if (PHK(0)) { fresh_lane(C); p0_prologue(C); } break;
        case 1: if (PHK(1)) { fresh_lane(C); norm1_phase(C, l); if (l == 1) { const int NB0 = moe_tables(C, 0); const int done = cvt_n6() + cvt_n7() + cvt_idle(NB0 * 8, C.G) * NWAVES * CVT_Q9 + cvt_idle(NB0 * 4, C.G) * NWAVES * CVT_Q10;
            fresh_lane(C); for (int it = done + C.gw; it < CVT_ITEMS; it += C.NGW) cvt_layer_item(C, 1, it); } } break;
        case 2: if (PHK(2)) { PitchSched S{(const char*)WSP(bf16, WS_H), (const char*)(wb + WB_IN), NTOK / 256, INP / 256, 512  , C.G, (int)blockIdx.x, 1024u};
            EpiWin E{WSP(bf16, WS_P), WSP(bf16, WS_CKVN), WSP(float, WS_MQ), WSP(bf16, WS_SK), WSP(bf16, WS_SV), WSP(bf16, WS_SQ), WSP(bf16, WS_U), C.in[I_KVNORM] + l * 256, C.in[I_SKN] + l * 64, C.in[I_SQN] + l * 64,
                     WSP(float, WS_ROPE), WSP(float, WS_ROPE) + 2048 * 32, (LAS float*)(C.lds + LDSCTL_OFF + 4096)};
            pg8::gemm_phase<EpiWin, PitchSched, true, true>(C.lds, 1024, S, E, C.wave); } break;
        case 4: if (PHK(4)) {
            { DenseSched S{(const char*)WSP(bf16, WS_CKVN), (const char*)(wb + WB_UKV), NTOK / 256, 4, 256, C.G, (int)blockIdx.x};
              EpiKvUpN E{WSP(bf16, WS_KMLA), WSP(bf16, WS_VMLA), WSP(bf16, WS_P), C.in[I_KHN] + l * 192, WSP(float, WS_ROPE), WSP(float, WS_ROPE) + 2048 * 32, (LAS float*)(C.lds + LDSCTL_OFF + 4096)};
              pg8::gemm_phase<EpiKvUpN, DenseSched, false>(C.lds, 256, S, E, C.wave); }
            { PitchSched S{(const char*)(WSP(bf16, WS_P) + NP_CQ), (const char*)(wb + WB_UQ), (last ? TL : NTOK) / 256, 3, 384, C.G, (int)((blockIdx.x + C.G - 32) % C.G), (unsigned)(INP * 2)};
              EpiStoreBf16 E{WSP(bf16, WS_QRAW), 768}; pg8::gemm_phase<EpiStoreBf16, PitchSched, true>(C.lds, 384, S, E, C.wave); }
        } break;
        case 6: if (PHK(6)) { fresh_lane(C); attn_phase(C, l); if (l == 0 && C.vcu >= 32) { fresh_lane(C); cvt_static(C, 0, (C.vcu - 32) * NWAVES + C.wave, 224 * NWAVES, CVT_Q6); } } break;
        case 7: if (PHK(7)) { PitchSched S{(const char*)WSP(bf16, WS_CAT), (const char*)(wb + WB_OUT), (last ? TL : NTOK) / 256, 4, 512, C.G, (int)blockIdx.x, 1024u};
            EpiOutRes E{C.in[I_X], C.in[I_CTX], WSP(bf16, WS_XS), WSP(bf16, WS_XS), ada_l, l == 0};
            pg8::gemm_phase<EpiOutRes, PitchSched, true, true>(C.lds, 1024, S, E, C.wave);
            if (l == 0 && (int)blockIdx.x >= 32) { fresh_lane(C); cvt_static(C, cvt_n6(), ((int)blockIdx.x - 32) * NWAVES + C.wave, 224 * NWAVES, CVT_Q7); } } break;
        case 8: if (PHK(8)) { fresh_lane(C); router_phase(C, l, reps > 1 && rep == 0); } break;
        case 9: if (PHK(9)) { fresh_lane(C); const int NB = moe_tables(C, l); MoeTab T{(const LAS int*)(C.lds + TAB_OFF), (const LAS int*)(C.lds + TAB_OFF) + 32, (const LAS int*)(C.lds + TAB_OFF) + 68};
            MoeSched<true> S{(const char*)(C.ws + WS_HF8), (const char*)(wb + WB_W1), WSP(int, WS_LISTE), T, NB, 8, C.G, (int)blockIdx.x};
            EpiMoe1 E{WSP(bf16, WS_ACT), C.in[I_B1] + (size_t)l * NE * 2048, T}; pg8::gemm_phase<EpiMoe1, MoeSched<true>, true, true>(C.lds, 1024, S, E, C.wave);
            { const int rem = (NB * 8) % C.G; if (l == 0 && rem && (int)blockIdx.x >= rem) { fresh_lane(C); cvt_static(C, cvt_n6() + cvt_n7(), ((int)blockIdx.x - rem) * NWAVES + C.wave, (C.G - rem) * NWAVES, CVT_Q9); } } } break;
        case 10: if (PHK(10)) { fresh_lane(C); const int NB = (MK_N_LAUNCHES > 1) ? moe_tables(C, l) : __builtin_amdgcn_readfirstlane(((const LAS int*)(C.lds + TAB_OFF))[68 + MAXBLK]);     MoeTab T{(const LAS int*)(C.lds + TAB_OFF), (const LAS int*)(C.lds + TAB_OFF) + 32, (const LAS int*)(C.lds + TAB_OFF) + 68};
            MoeSched<false> S{(const char*)WSP(bf16, WS_ACT), (const char*)(wb + WB_W2), WSP(int, WS_LISTE), T, NB, 4, C.G, (int)blockIdx.x};
            EpiMoe2 E{WSP(bf16, WS_YK), C.in[I_B2] + (size_t)l * NE * 1024, WSP(float, WS_ROUTEG), WSP(int, WS_LISTE), T}; pg8::gemm_phase<EpiMoe2, MoeSched<false>, true, true>(C.lds, 1024, S, E, C.wave);
            { const int rem = (NB * 4) % C.G; if (l == 0 && rem && (int)blockIdx.x >= rem) { fresh_lane(C); cvt_static(C, cvt_n6() + cvt_n7() + cvt_idle(NB * 8, C.G) * NWAVES * CVT_Q9, ((int)blockIdx.x - rem) * NWAVES + C.wave, (C.G - rem) * NWAVES, CVT_Q10); } } } break;
        default: if (PHK(11)) { fresh_lane(C); final_phase(C); } break;
        }
        }
        if (ph + 1 < hi) { fresh_lane(C); xcd_barrier(bar, C.tid); }
    }
#undef PHK
}

extern "C" void kernel_launch(void* const* d_in, const int* in_sizes, int n_in, void* d_out, int out_size, void* d_ws, size_t ws_size, hipStream_t stream) {
    static int grid = 0;
    if (grid == 0) {
        if (n_in != 29 || in_sizes[0] != TL * DM || out_size != TL * DM || ws_size < WS_END) { fprintf(stderr, "kernel_launch: unexpected shapes (n_in %d, in0 %d, out %d, ws %zu < %zu?)\n", n_in, n_in > 0 ? in_sizes[0] : -1, out_size, ws_size, (size_t)WS_END); grid = -1; return; }
        int dev = 0, cus = 0, per_cu = 0;
        if (hipGetDevice(&dev) != hipSuccess || hipDeviceGetAttribute(&cus, hipDeviceAttributeMultiprocessorCount, dev) != hipSuccess) { grid = -1; return; }
        if (hipFuncSetAttribute((const void*)mk_fwd, hipFuncAttributeMaxDynamicSharedMemorySize, LDS_BYTES) != hipSuccess) { fprintf(stderr, "kernel_launch: hipFuncSetAttribute failed\n"); grid = -1; return; }
        if (hipOccupancyMaxActiveBlocksPerMultiprocessor(&per_cu, (const void*)mk_fwd, NTHREADS, LDS_BYTES) != hipSuccess || per_cu < 1) fprintf(stderr, "kernel_launch: occupancy query reports %d\n", per_cu);
        (void)hipGetLastError();
        grid = cus;
        if (grid != 256) fprintf(stderr, "kernel_launch: %d CUs; this kernel is built for 256\n", grid);
    }
    if (grid < 0) return;
    if (hipMemsetAsync((char*)d_ws + WS_CTL, 0, CTL_BYTES, stream) != hipSuccess) return;
    Args a{};
    for (int i = 0; i < 29; ++i) a.in[i] = (const float*)d_in[i];
    a.out = (float*)d_out; a.ws = (unsigned char*)d_ws;
#if MK_N_LAUNCHES == 1
    a.ph_lo = 0; a.ph_hi = N_PHASES;
    hipLaunchKernelGGL(mk_fwd, dim3(grid), dim3(NTHREADS), LDS_BYTES, stream, a);
#else
    for (int p = 0; p < N_PHASES; ++p) { a.ph_lo = p; a.ph_hi = p + 1; hipLaunchKernelGGL(mk_fwd, dim3(grid), dim3(NTHREADS), LDS_BYTES, stream, a); }
#endif
    const hipError_t le = hipPeekAtLastError();
    if (le != hipSuccess) fprintf(stderr, "kernel_launch: launch failed: %s\n", hipGetErrorName(le));
}
```

```cpp
#include <hip/hip_runtime.h>
#include <cstdio>
#include <cstdint>

#ifndef MK_N_LAUNCHES
#define MK_N_LAUNCHES 1
#endif

#define GAS __attribute__((address_space(1)))
#define LAS __attribute__((address_space(3)))
typedef unsigned short bf16;
typedef short bf16x8 __attribute__((ext_vector_type(8)));
typedef int i32x8 __attribute__((ext_vector_type(8)));
typedef int i32x4 __attribute__((ext_vector_type(4)));
typedef short s16x4 __attribute__((ext_vector_type(4)));
typedef float f32x4 __attribute__((ext_vector_type(4)));
typedef float f32x2 __attribute__((ext_vector_type(2)));
typedef float f32x16 __attribute__((ext_vector_type(16)));
typedef unsigned u32x4 __attribute__((ext_vector_type(4)));
typedef unsigned u32x2 __attribute__((ext_vector_type(2)));

constexpr int DM = 1024, NBATCH = 8, SEQ = 2048, NCTX = 256;
constexpr int TL = NBATCH * SEQ, TC = NBATCH * NCTX, NTOK = TL + TC, NKEY = NCTX + SEQ;
constexpr int INC = 1728, INP = 1792;
constexpr int O_KROPE = 256, O_SK = 320, O_CQ = 576, O_SQ = 960, O_GLU = 1216;
constexpr int NE = 32, NLAYER = 2;
constexpr float EPS = 1e-6f;
constexpr int NWAVES = 8, NTHREADS = 512;

constexpr size_t KiB = 1024, MiB = 1024 * 1024;
constexpr size_t WS_CTL = 0, CTL_BYTES = 1 * MiB;
constexpr int CW_BAR = 4096;
constexpr int CW_CNT = 8192;
constexpr size_t WS_ADA = 1 * MiB;
constexpr size_t WS_ROPE = 2 * MiB;
constexpr size_t WS_ROUTEG = 3 * MiB;
constexpr size_t WS_LISTE = 4 * MiB;
constexpr size_t WS_W = 8 * MiB;
constexpr size_t WB_IN = 0, WB_UKV = WB_IN + (size_t)INP * 1024 * 2, WB_UQ = WB_UKV + (size_t)1024 * 256 * 2, WB_OUT = WB_UQ + (size_t)768 * 384 * 2,
                 WB_W1 = WB_OUT + (size_t)1024 * 1024 * 2, WB_W2 = WB_W1 + (size_t)NE * 2048 * 1024 * 2, WB_LAYER = WB_W2 + (size_t)NE * 1024 * 1024 * 2;
static_assert(WB_LAYER % 256 == 0, "align");
constexpr size_t WS_XC = WS_W + 2 * WB_LAYER;
constexpr size_t WS_H = WS_XC + (size_t)TC * DM * 4;
constexpr size_t WS_P = WS_H + (size_t)NTOK * DM * 2;
constexpr size_t WS_CKVN = WS_P + (size_t)NTOK * INP * 2;
constexpr size_t WS_CQN = WS_CKVN + (size_t)NTOK * 256 * 2;
constexpr size_t WS_KRAW = WS_CQN + (size_t)NTOK * 384 * 2;
constexpr size_t WS_GSLOT = WS_CQN;
constexpr size_t WS_MQ = WS_KRAW;
constexpr size_t WS_QRAW = WS_KRAW + (size_t)NTOK * 512 * 2;
constexpr size_t WS_KMLA = WS_QRAW + (size_t)NTOK * 768 * 2;
constexpr size_t WS_VMLA = WS_KMLA + (size_t)32 * NKEY * 192 * 2;
constexpr size_t WS_QMLA = WS_VMLA + (size_t)32 * NKEY * 128 * 2;
constexpr size_t WS_SK = WS_QMLA + (size_t)32 * NKEY * 192 * 2;
constexpr size_t WS_SV = WS_SK + (size_t)16 * NKEY * 64 * 2;
constexpr size_t WS_SQ = WS_SV + (size_t)16 * NKEY * 64 * 2;
constexpr size_t WS_U = WS_SQ + (size_t)32 * NKEY * 64 * 2;
constexpr size_t WS_CAT = WS_U + (size_t)NTOK * 256 * 2;
constexpr size_t WS_ACT = WS_CAT + (size_t)NTOK * DM * 2;
constexpr int MAXBLK = 320;
constexpr size_t WS_YK = WS_ACT + (size_t)MAXBLK * 256 * 1024 * 2;
constexpr size_t WS_HF8 = WS_YK + (size_t)NTOK * 4 * 1024 * 2;
constexpr size_t WS_XS = WS_HF8 + (size_t)NTOK * 1024;
constexpr size_t WS_END = WS_XS + (size_t)NTOK * 1024 * 2;
static_assert(WS_XC % 256 == 0 && WS_P % 256 == 0 && WS_KMLA % 256 == 0 && WS_ACT % 256 == 0 && WS_YK % 256 == 0, "align");

constexpr int RING_BYTES = 131072;
constexpr int LDSCTL_OFF = RING_BYTES;
constexpr int MISC_OFF = LDSCTL_OFF;
constexpr int TAB_OFF = LDSCTL_OFF + 128;
constexpr int LDS_BYTES = 147456;

#define LDS_WAIT() asm volatile("s_waitcnt lgkmcnt(0)" ::: "memory")
#define VM_WAIT() asm volatile("s_waitcnt vmcnt(0)" ::: "memory")
__device__ __forceinline__ unsigned f2bf(float f) { unsigned u = __builtin_bit_cast(unsigned, f); return (u + 0x7fffu + ((u >> 16) & 1u)) >> 16; }
__device__ __forceinline__ unsigned pk2(float lo, float hi) { unsigned r; asm("v_cvt_pk_bf16_f32 %0, %1, %2" : "=v"(r) : "v"(lo), "v"(hi)); return r; }
__device__ __forceinline__ float bflo(unsigned w) { return __builtin_bit_cast(float, w << 16); }
__device__ __forceinline__ float bfhi(unsigned w) { return __builtin_bit_cast(float, w & 0xffff0000u); }
__device__ __forceinline__ unsigned cvt_pk_bf16(float lo, float hi) { unsigned r; asm volatile("v_cvt_pk_bf16_f32 %0, %1, %2" : "=v"(r) : "v"(lo), "v"(hi)); return r; }
__device__ __forceinline__ unsigned pk4_f8(float a, float b, float c, float d) { int w = __builtin_amdgcn_cvt_pk_fp8_f32(a, b, 0, false); w = __builtin_amdgcn_cvt_pk_fp8_f32(c, d, w, true); return (unsigned)w; }
template <int X> __device__ __forceinline__ float swz_xor(float v) { return __builtin_bit_cast(float, __builtin_amdgcn_ds_swizzle(__builtin_bit_cast(int, v), (X << 10) | 0x1f)); }
__device__ __forceinline__ float xhalf(float v) {
    unsigned a = __builtin_bit_cast(unsigned, v), b = a; asm volatile("" : "+v"(b));
    auto rr = __builtin_amdgcn_permlane32_swap(a, b, false, false);
    const unsigned own = __builtin_bit_cast(unsigned, v);
    return __builtin_bit_cast(float, rr[0] == own ? rr[1] : rr[0]);
}
template <int CTRL> __device__ __forceinline__ float dpp_mov(float v) { return __builtin_bit_cast(float, __builtin_amdgcn_update_dpp(0, __builtin_bit_cast(int, v), CTRL, 0xF, 0xF, false)); }
__device__ __forceinline__ float row16_sum(float v) { v += dpp_mov<0xB1>(v); v += dpp_mov<0x4E>(v); v += dpp_mov<0x124>(v); v += dpp_mov<0x128>(v); return v; }
__device__ __forceinline__ float row16_max(float v) { v = fmaxf(v, dpp_mov<0xB1>(v)); v = fmaxf(v, dpp_mov<0x4E>(v)); v = fmaxf(v, dpp_mov<0x124>(v)); v = fmaxf(v, dpp_mov<0x128>(v)); return v; }
__device__ __forceinline__ float rdl(float v, int l) { return __builtin_bit_cast(float, __builtin_amdgcn_readlane(__builtin_bit_cast(int, v), l)); }
__device__ __forceinline__ float wave_sum(float v) { v = row16_sum(v); return (rdl(v, 0) + rdl(v, 16)) + (rdl(v, 32) + rdl(v, 48)); }
__device__ __forceinline__ float grp16_sum(float v) { return row16_sum(v); }
__device__ __forceinline__ float wave_max(float v) { v = row16_max(v); return fmaxf(fmaxf(rdl(v, 0), rdl(v, 16)), fmaxf(rdl(v, 32), rdl(v, 48))); }
__device__ __forceinline__ int lane_id_now() { int l; asm volatile("v_mbcnt_lo_u32_b32 %0, -1, 0\n\tv_mbcnt_hi_u32_b32 %0, -1, %0" : "=v"(l)); return l; }
__device__ __forceinline__ float sigmoidf_(float x) { return __builtin_amdgcn_rcpf(1.f + __builtin_amdgcn_exp2f(x * -1.4426950408889634f)); }

#define XB_TMO      128
#define XB_XCNT(j)  (256  + 64 * (j))
#define XB_XSUB(j)  (1280 + 64 * (j))
#define XB_XGEN(j)  (2304 + 64 * (j))
#define XB_TOP      3328
#define XB_TOPGEN   3392
#define XCD_BAR_WORDS 3456
#define XB_SPIN_CAP (1u << 18)
__device__ __forceinline__ unsigned xb_ld(unsigned* p)              { return __hip_atomic_load(p, __ATOMIC_RELAXED, __HIP_MEMORY_SCOPE_AGENT); }
__device__ __forceinline__ unsigned xb_add(unsigned* p, unsigned v) { return __hip_atomic_fetch_add(p, v, __ATOMIC_RELAXED, __HIP_MEMORY_SCOPE_AGENT); }
__device__ __forceinline__ unsigned xb_xcc_id() { return (unsigned)__builtin_amdgcn_s_getreg((3 << 11) | 20) & 0xFu; }
#define XB_SPIN(cond, bar) do { unsigned _sp = 0; while (cond) { __builtin_amdgcn_s_sleep(1); \
    if ((++_sp & 255u) == 0u) { if (xb_ld(&(bar)[XB_TMO])) break; if (_sp > XB_SPIN_CAP) { atomicAdd(&(bar)[XB_TMO], 1u); break; } } } } while (0)
struct XcdBarrier { unsigned* bar; unsigned x; volatile LAS unsigned* st; };
__device__ __forceinline__ XcdBarrier xcd_barrier_post(unsigned* bar, volatile LAS unsigned* st, const int tid) {
    XcdBarrier b; b.bar = bar; b.x = xb_xcc_id(); b.st = st;
    if (tid == 0) (void)xb_add(&bar[XB_XCNT(b.x)], 1u);
    return b;
}
__device__ __forceinline__ void xcd_barrier_complete(unsigned* bar, unsigned x, unsigned& nloc, unsigned& nx) {
    const unsigned G = gridDim.x * gridDim.y * gridDim.z;
    unsigned sum, cnt, mine, sp = 0u;
    for (;;) {
        sum = 0u; cnt = 0u; mine = 0u;
#pragma unroll
        for (unsigned j = 0; j < 16; ++j) { const unsigned c = xb_ld(&bar[XB_XCNT(j)]); sum += c; cnt += (c > 0u) ? 1u : 0u; mine = (j == x) ? c : mine; }
        if (sum == G) break;
        __builtin_amdgcn_s_sleep(1);
        if ((++sp & 255u) == 0u) { if (xb_ld(&bar[XB_TMO])) break; if (sp > XB_SPIN_CAP) { atomicAdd(&bar[XB_TMO], 1u); break; } }
    }
    nloc = mine > 0u ? mine : 1u; nx = cnt > 0u ? cnt : 1u;
}
__device__ __forceinline__ void xcd_barrier(const XcdBarrier& b, const int tid) {
    asm volatile("s_waitcnt vmcnt(0)" ::: "memory");
    __syncthreads();
    if (tid == 0) {
        unsigned* bar = b.bar;
        __builtin_amdgcn_s_waitcnt(0);
        unsigned nloc = b.st[0], nx = b.st[1];
        if (nloc == 0u) { xcd_barrier_complete(bar, b.x, nloc, nx); b.st[0] = nloc; b.st[1] = nx; }
        const unsigned old = xb_add(&bar[XB_XSUB(b.x)], 1u);
        const unsigned gen = old / nloc;
        if (old + 1u == (gen + 1u) * nloc) {
            __builtin_amdgcn_fence(__ATOMIC_RELEASE, "agent");
            asm volatile("s_waitcnt vmcnt(0)" ::: "memory");
            const unsigned og = xb_add(&bar[XB_TOP], 1u);
            const unsigned tg = og / nx;
            if (og + 1u == (tg + 1u) * nx) xb_add(&bar[XB_TOPGEN], 1u);
            else XB_SPIN(xb_ld(&bar[XB_TOPGEN]) == tg, bar);
            __builtin_amdgcn_fence(__ATOMIC_ACQUIRE, "agent");
            xb_add(&bar[XB_XGEN(b.x)], 1u);
            asm volatile("s_waitcnt vmcnt(0)" ::: "memory");
        } else {
            XB_SPIN(xb_ld(&bar[XB_XGEN(b.x)]) == gen, bar);
            __builtin_amdgcn_fence(__ATOMIC_ACQUIRE, "agent");
            asm volatile("s_waitcnt vmcnt(0)" ::: "memory");
        }
    }
    __syncthreads();
}

namespace pg8 {
constexpr int BM = 256, BK = 64, HALF = 128, HTB = HALF * BK * 2, STAGE_BYTES = 8 * HTB, NXCD = 8, WGM = 8;
__host__ __device__ __forceinline__ int lds_byte(int r, int c) { const int st = (r >> 4) * 2 + (c >> 5), rr = r & 15, cc = c & 31, ob = rr * 64 + cc * 2; return st * 1024 + (ob ^ (((ob >> 9) & 1) << 5)); }
__host__ __device__ __forceinline__ void stage_rc(int b, int& R, int& C) { const int st = b / 1024, sb = b % 1024, swz = sb ^ (((sb >> 9) & 1) << 5); R = (st >> 1) * 16 + swz / 64; C = (st & 1) * 32 + (swz % 64) / 2; }
__host__ __device__ __forceinline__ int perm32(int rho) { const int n = rho >> 4, i = rho & 15; return 8 * (i >> 2) + 4 * n + (i & 3); }

__device__ __forceinline__ i32x8 f8op(bf16x8 lo, bf16x8 hi) { const i32x4 a = __builtin_bit_cast(i32x4, lo), b = __builtin_bit_cast(i32x4, hi); return (i32x8){a[0], a[1], a[2], a[3], b[0], b[1], b[2], b[3]}; }
struct Unit { int pm, pn; const char* A; const char* B; int par; };

__device__ __forceinline__ void order_map(int L, int nM, int nN, int& pm, int& pn) {
    const int nwg = nM * nN; int wgid = L;
    { const int q = nwg / NXCD, r = nwg % NXCD, xcd = wgid % NXCD, off = wgid / NXCD; wgid = (xcd < r ? xcd * (q + 1) : r * (q + 1) + (xcd - r) * q) + off; }
    const int nig = WGM * nN, gid = wgid / nig, fm = gid * WGM, gsz = (nM - fm) < WGM ? (nM - fm) : WGM;
    pm = fm + ((wgid % nig) % gsz); pn = (wgid % nig) / gsz;
}

template <class Epi, class Sched, bool GATHER, bool F8 = false>
__device__ __forceinline__ void gemm_phase(LAS unsigned char* lds, const int Kel, const Sched& S, const Epi& E, const int wid_in  ) {
    const int K = F8 ? Kel / 2 : Kel;
    int wid = wid_in; asm volatile("" : "+s"(wid));
    const int lane = lane_id_now(), tid = wid * 64 + lane;
    const int wr = wid >> 2, wc = wid & 3, fr = lane & 15, fq = lane >> 4;
    const int nt = K / BK;
    unsigned voffB[2], vA0[2], vA1[2];
    const size_t hstep = (size_t)HALF * K * 2;
#pragma unroll
    for (int i = 0; i < 2; ++i) { int R, C; stage_rc(tid * 16 + i * 8192, R, C); const int Rb = Epi::PERM ? ((R & ~31) + perm32(R & 31)) : R;
        voffB[i] = (unsigned)(Rb * K + C) * 2u; vA0[i] = (unsigned)(R * K + C) * 2u; vA1[i] = vA0[i] + (unsigned)hstep; }
    const size_t kstep = (size_t)(BK * 2);
    const unsigned ldsw = (unsigned)wid * 1024u;
    const int aoff = lds_byte(wr * 64 + fr, F8 ? fq * 16 : fq * 8), boff = lds_byte(wc * 32 + fr, F8 ? fq * 16 : fq * 8);
#define PG8_SA(b, h) (((b) * 2 + (h)) * HTB)
#define PG8_SB(b, h) ((4 + (b) * 2 + (h)) * HTB)
#define PG8_STAGE(bufoff, gbase, voff) do { _Pragma("unroll") for (int _i = 0; _i < 2; ++_i) { \
        asm volatile("s_mov_b32 m0, %0\n\ts_nop 0\n\tglobal_load_lds_dwordx4 %1, %2" \
            :: "s"((unsigned)(uintptr_t)(lds + (bufoff) + _i * 8192) + ldsw), "v"((voff)[_i]), "s"((const char*)(gbase)) : "memory"); } } while (0)
#define PG8_STAGE_SEL(bufoff, gbase, sel, vn, vc) do { _Pragma("unroll") for (int _i = 0; _i < 2; ++_i) \
        __builtin_amdgcn_global_load_lds((const unsigned*)((const char*)(gbase) + ((sel) ? (vn)[_i] : (vc)[_i])), (LAS unsigned*)(lds + (bufoff) + ldsw + _i * 8192), 16, 0, 0); } while (0)
#define PG8_LD8(p) __builtin_shufflevector(*(const LAS i32x4*)(p), *(const LAS i32x4*)((p) + 16), 0, 1, 2, 3, 4, 5, 6, 7)
#define PG8_LDA(dst, b, h) do { if constexpr (F8) { _Pragma("unroll") for (int m = 0; m < 4; ++m) dst##8[m] = PG8_LD8(lds + PG8_SA(b, h) + aoff + m * 2048); } \
        else { _Pragma("unroll") for (int m = 0; m < 4; ++m) _Pragma("unroll") for (int k = 0; k < 2; ++k) dst[m][k] = *(const LAS bf16x8*)(lds + PG8_SA(b, h) + aoff + m * 2048 + k * 1024); } } while (0)
#define PG8_LDB(dst, b, h) do { if constexpr (F8) { _Pragma("unroll") for (int n = 0; n < 2; ++n) dst##8[n] = PG8_LD8(lds + PG8_SB(b, h) + boff + n * 2048); } \
        else { _Pragma("unroll") for (int n = 0; n < 2; ++n) _Pragma("unroll") for (int k = 0; k < 2; ++k) dst[n][k] = *(const LAS bf16x8*)(lds + PG8_SB(b, h) + boff + n * 2048 + k * 1024); } } while (0)
#define PG8_MMA(ai, bj, At, Bt) do { __builtin_amdgcn_s_setprio(1); if constexpr (F8) { _Pragma("unroll") for (int m = 0; m < 4; ++m) _Pragma("unroll") for (int n = 0; n < 2; ++n) \
            acc[ai][bj][m][n] = __builtin_amdgcn_mfma_scale_f32_16x16x128_f8f6f4(Bt##8[n], At##8[m], acc[ai][bj][m][n], 0, 0, 0, 0x7A7A7A7A, 0, 0x7A7A7A7A); } \
        else { _Pragma("unroll") for (int m = 0; m < 4; ++m) _Pragma("unroll") for (int n = 0; n < 2; ++n) _Pragma("unroll") for (int k = 0; k < 2; ++k) \
            acc[ai][bj][m][n] = __builtin_amdgcn_mfma_f32_16x16x32_bf16(Bt[n][k], At[m][k], acc[ai][bj][m][n], 0, 0, 0); } __builtin_amdgcn_s_setprio(0); } while (0)
#define PG8_WAIT_V(n) asm volatile("s_waitcnt vmcnt(" #n ")" ::: "memory")
#define PG8_WAIT_L(n) asm volatile("s_waitcnt lgkmcnt(" #n ")" ::: "memory")
#define PG8_BAR __builtin_amdgcn_s_barrier()
#define PG8_SCHED __builtin_amdgcn_sched_barrier(0)
    Unit cur, nxt; int ui = 0;
    if (!S.next(0, cur)) return;
    f32x4 acc[2][2][4][2];
    if constexpr (Epi::INIT) { const int l2 = lane_id_now(); const typename Epi::PreT pr0 = E.pre(cur, wr, wc, l2 & 15, l2 >> 4); E.init(acc, pr0); }
    else {
#pragma unroll
    for (int a = 0; a < 2; ++a)
#pragma unroll
        for (int b = 0; b < 2; ++b)
#pragma unroll
            for (int m = 0; m < 4; ++m)
#pragma unroll
                for (int n = 0; n < 2; ++n) { float z = 0.f; asm volatile("" : "+v"(z)); acc[a][b][m][n] = (f32x4){z, z, z, z}; }
    }
    bf16x8 At[4][2], B0[2][2], B1[2][2]; i32x8 At8[4], B08[2], B18[2];
    const char* cA = cur.A; const char* cB = cur.B;
    if constexpr (GATHER) { S.list_prefetch(cur, lds, wid, cur.par); }
    if constexpr (GATHER) {
#pragma unroll
        for (int i = 0; i < 2; ++i) { int R, C; stage_rc(tid * 16 + i * 8192, R, C); vA0[i] = S.row_off(cur, R) + (unsigned)C * 2u; vA1[i] = S.row_off(cur, HALF + R) + (unsigned)C * 2u; }
    }
    PG8_STAGE(PG8_SB(0, 0), cB, voffB); PG8_STAGE(PG8_SB(0, 1), cB + hstep, voffB); PG8_STAGE(PG8_SA(0, 0), cA, vA0); PG8_STAGE(PG8_SA(0, 1), cA, vA1);
    if (wr == 1) PG8_BAR;
    PG8_WAIT_V(2); PG8_BAR;
    PG8_STAGE(PG8_SB(1, 0), cB + kstep, voffB); PG8_STAGE(PG8_SA(1, 0), cA + kstep, vA0); PG8_STAGE(PG8_SB(1, 1), cB + hstep + kstep, voffB);
    PG8_WAIT_V(6); PG8_BAR;
    for (;;) {
        const bool has_next = S.next(ui + 1, nxt);

        const char* nA = has_next ? nxt.A : cA; const char* nB = has_next ? nxt.B : cB;
#pragma nounroll
        for (int t = 0; t < nt; t += 2) {
            const bool last = (t == nt - 2);
            const char* a1 = cA + (size_t)(t + 1) * kstep;
            const char* a2 = last ? nA : cA + (size_t)(t + 2) * kstep; const char* b2 = last ? nB : cB + (size_t)(t + 2) * kstep;
            const char* a3 = a2 + kstep; const char* b3 = b2 + kstep;
            PG8_LDB(B0, 0, 0); PG8_LDB(B1, 0, 1); PG8_SCHED; PG8_LDA(At, 0, 0); PG8_STAGE(PG8_SA(1, 1), a1, vA1);
            if constexpr (GATHER) { if (last && has_next) {
#pragma unroll
                for (int i = 0; i < 2; ++i) { int R, C; stage_rc(tid * 16 + i * 8192, R, C); vA0[i] = S.row_off_next(nxt, R, lds, nxt.par) + (unsigned)C * 2u; vA1[i] = S.row_off_next(nxt, HALF + R, lds, nxt.par) + (unsigned)C * 2u; } } }
            PG8_WAIT_V(8); PG8_WAIT_L(0); PG8_BAR;
            if constexpr (GATHER) { if (t == 0 && has_next) S.list_prefetch(nxt, lds, wid, nxt.par); }
            PG8_MMA(0, 0, At, B0); PG8_MMA(0, 1, At, B1); PG8_BAR; PG8_SCHED;
            PG8_LDA(At, 0, 1); PG8_STAGE(PG8_SB(0, 0), b2, voffB); PG8_STAGE(PG8_SB(0, 1), b2 + hstep, voffB); PG8_STAGE(PG8_SA(0, 0), a2, vA0);
            PG8_WAIT_V(8); PG8_WAIT_L(0); PG8_BAR; PG8_MMA(1, 0, At, B0); PG8_MMA(1, 1, At, B1); PG8_BAR; PG8_SCHED;
            PG8_LDB(B0, 1, 0); PG8_LDB(B1, 1, 1); PG8_SCHED; PG8_LDA(At, 1, 0); PG8_STAGE(PG8_SA(0, 1), a2, vA1);
            PG8_WAIT_V(8); PG8_WAIT_L(0); PG8_BAR; PG8_MMA(0, 0, At, B0); PG8_MMA(0, 1, At, B1); PG8_BAR; PG8_SCHED;
            PG8_LDA(At, 1, 1); PG8_STAGE(PG8_SB(1, 0), b3, voffB); PG8_STAGE(PG8_SB(1, 1), b3 + hstep, voffB); PG8_STAGE(PG8_SA(1, 0), a3, vA0);
            PG8_WAIT_V(8); PG8_WAIT_L(0); PG8_BAR; PG8_MMA(1, 0, At, B0); PG8_MMA(1, 1, At, B1); PG8_BAR; PG8_SCHED;
        }
        if (wr == 0) PG8_BAR;
        typename Epi::PreT prn{};
        { const int l2 = lane_id_now();
          if constexpr (Epi::INIT) { if (has_next) prn = E.pre(nxt, wr, wc, l2 & 15, l2 >> 4); }
          E(acc, cur, wr, wc, l2 & 15, l2 >> 4); }
        if (!has_next) break;
        if constexpr (Epi::INIT) E.init(acc, prn);
        else {
#pragma unroll
        for (int a = 0; a < 2; ++a)
#pragma unroll
            for (int b = 0; b < 2; ++b)
#pragma unroll
                for (int m = 0; m < 4; ++m)
#pragma unroll
                    for (int n = 0; n < 2; ++n) { float z = 0.f; asm volatile("" : "+v"(z)); acc[a][b][m][n] = (f32x4){z, z, z, z}; }
        }
        cur = nxt; cA = nA; cB = nB; ++ui;
        if (wr == 1) PG8_BAR;
    }
    PG8_WAIT_V(0);
    PG8_BAR;
#undef PG8_SA
#undef PG8_SB
#undef PG8_STAGE
#undef PG8_STAGE_SEL
#undef PG8_LDA
#undef PG8_LDB
#undef PG8_MMA
#undef PG8_WAIT_V
#undef PG8_WAIT_L
#undef PG8_BAR
#undef PG8_SCHED
}
}

namespace att {
#define SBAR() __builtin_amdgcn_sched_barrier(0)
__device__ __forceinline__ int crow(int r, int hi) { return (r & 3) + 8 * (r >> 2) + 4 * hi; }
template <int OFF> __device__ __forceinline__ s16x4 tr_read(int vb) {
    s16x4 r; asm volatile("ds_read_b64_tr_b16 %0, %1 offset:%2" : "=&v"(r) : "v"(vb), "i"(OFF) : "memory"); return r;
}
__device__ __forceinline__ int v_rd_base(int lane) { return ((lane & 3) << 3) | (((lane >> 2) & 3) << 6) | (((lane >> 4) & 1) << 5) | (((lane >> 5) & 1) << 8); }

template <int DQK, int DV, bool MASK, bool SINK> struct Body {
    static constexpr int KROW = DQK * 2, SHM_K = 64 * DQK * 2, SHM_V = 64 * DV * 2, NKC = 64 * DQK / 8 / 512, NVC = 64 * DV / 8 / 512, ND0 = DV / 32, NQ = DQK / 16;
    static constexpr int VU = (DV / 32) * 512;
    static constexpr int NQL = (DQK > 64) ? 4 : 0, NQR = NQ - NQL;
    static constexpr int QL_OFF = 2 * SHM_K + 2 * SHM_V + NWAVES * 64 * 4, LDS_NEED = QL_OFF + NWAVES * NQL * 64 * 16;
    static constexpr float SCALE = (DQK == 192) ? 0.07216878364870322f : 0.125f;
    static constexpr float THR = (DQK == 192) ? 5.5f : 8.f;
    static __device__ __forceinline__ int kswz(int row, int colB) { return row * KROW + (colB ^ (((row >> 1) & 7) << 4)); }
    static __device__ __forceinline__ int v_st(int k, int c) { const int kk = (k & ~0xC) | ((k & 4) << 1) | ((k & 8) >> 1); return ((kk >> 3) * ND0 + (c >> 5)) * 512 + ((kk & 7) * 32 + (c & 31)) * 2; }
    static constexpr int v_rd_off(int d0, int ks, int half) { return d0 * 512 + ks * (2 * VU) + half * VU; }

    static __device__ __forceinline__ void partialSM(f32x16& p0, f32x16& p1, float& m_reg, float& mn, float& alpha, bool domask, int drel, int hi) {
        constexpr float C = SCALE * 1.4426950408889634f;
        if (MASK) { if (domask) {
#pragma unroll
            for (int r = 0; r < 16; ++r) { const int rel = drel + crow(r, hi); if ((unsigned)(rel + 128) > 256u) p0[r] = -INFINITY; if ((unsigned)(rel + 32 + 128) > 256u) p1[r] = -INFINITY; }
        } }
        float pmax = p0[0];
#pragma unroll
        for (int r = 1; r < 16; ++r) pmax = fmaxf(pmax, p0[r]);
#pragma unroll
        for (int r = 0; r < 16; ++r) pmax = fmaxf(pmax, p1[r]);
        { unsigned xa = __float_as_uint(pmax), xb = xa; asm volatile("" : "+v"(xb));
          auto rr = __builtin_amdgcn_permlane32_swap(xa, xb, false, false);
          pmax = fmaxf(__uint_as_float(rr[0]), __uint_as_float(rr[1])); }
        if (__builtin_expect(__all(pmax - m_reg <= THR / SCALE), 1)) { mn = m_reg; alpha = 1.f; }
        else { mn = fmaxf(m_reg, pmax); alpha = __builtin_amdgcn_exp2f((m_reg - mn) * C); m_reg = mn; }
        const float mnC = -mn * C;
#pragma unroll
        for (int r = 0; r < 16; ++r) p0[r] = fmaf(p0[r], C, mnC);
#pragma unroll
        for (int r = 0; r < 16; ++r) p1[r] = fmaf(p1[r], C, mnC);
#pragma unroll
        for (int r = 0; r < 16; ++r) p0[r] = __builtin_amdgcn_exp2f(p0[r]);
    }
    static __device__ __forceinline__ void finishSM(f32x16& p0, f32x16& p1, float alpha, float& l_reg, bf16x8& pa0, bf16x8& pa1, bf16x8& pa2, bf16x8& pa3) {
#pragma unroll
        for (int r = 0; r < 16; ++r) p1[r] = __builtin_amdgcn_exp2f(p1[r]);
        float ps = 0;
#pragma unroll
        for (int r = 0; r < 16; ++r) ps += p0[r];
#pragma unroll
        for (int r = 0; r < 16; ++r) ps += p1[r];
        { unsigned xa = __float_as_uint(ps), xb = xa; asm volatile("" : "+v"(xb));
          auto rr = __builtin_amdgcn_permlane32_swap(xa, xb, false, false);
          ps = __uint_as_float(rr[0]) + __uint_as_float(rr[1]); }
        l_reg = l_reg * alpha + ps;
#define PK4(P, BASE, OUT) do { unsigned a0 = cvt_pk_bf16(P[BASE + 0], P[BASE + 1]), a1 = cvt_pk_bf16(P[BASE + 2], P[BASE + 3]);   \
    unsigned b0 = cvt_pk_bf16(P[BASE + 4], P[BASE + 5]), b1 = cvt_pk_bf16(P[BASE + 6], P[BASE + 7]);                              \
    auto r0 = __builtin_amdgcn_permlane32_swap(a0, b0, false, false); auto r1 = __builtin_amdgcn_permlane32_swap(a1, b1, false, false); \
    u32x4 w = {r0[0], r1[0], r0[1], r1[1]}; OUT = *reinterpret_cast<bf16x8*>(&w); } while (0)
        PK4(p0, 0, pa0); PK4(p0, 8, pa1); PK4(p1, 0, pa2); PK4(p1, 8, pa3);
#undef PK4
    }
    template <int D0> static __device__ __forceinline__ void qk_steps(f32x16& p0, f32x16& p1, bf16x8 ka0, bf16x8 ka1, bf16x8 qa, const LAS char* Ks, const int (&kb)[4], const bf16x8* qr, const LAS char* ql) {
        bf16x8 kn0 = ka0, kn1 = ka1, qn = qa;
        if constexpr (D0 + 1 < NQ) { constexpr int d1 = D0 + 1;
            kn0 = *reinterpret_cast<const LAS bf16x8*>(Ks + kb[d1 & 3] + (d1 >> 2) * 128);
            kn1 = *reinterpret_cast<const LAS bf16x8*>(Ks + kb[d1 & 3] + (d1 >> 2) * 128 + 32 * KROW);
            if constexpr (d1 < NQR) qn = qr[d1]; else qn = *reinterpret_cast<const LAS bf16x8*>(ql + (d1 - NQR) * 1024); }
        p0 = __builtin_amdgcn_mfma_f32_32x32x16_bf16(ka0, qa, p0, 0, 0, 0);
        p1 = __builtin_amdgcn_mfma_f32_32x32x16_bf16(ka1, qa, p1, 0, 0, 0);
        if constexpr (D0 + 1 < NQ) {
            __builtin_amdgcn_sched_group_barrier(0x100, (D0 + 1 >= NQR) ? 3 : 2, 0);
            __builtin_amdgcn_sched_group_barrier(0x008, 2, 0);
            qk_steps<D0 + 1>(p0, p1, kn0, kn1, qn, Ks, kb, qr, ql);
        } else { __builtin_amdgcn_sched_group_barrier(0x008, 2, 0); }
    }
    static __device__ __forceinline__ void qkt(f32x16& p0, f32x16& p1, const LAS char* Ks, const int (&kb)[4], const bf16x8* qr, const LAS char* ql) {
        p0 = f32x16{}; p1 = f32x16{};
        const bf16x8 ka0 = *reinterpret_cast<const LAS bf16x8*>(Ks + kb[0]), ka1 = *reinterpret_cast<const LAS bf16x8*>(Ks + kb[0] + 32 * KROW);
        bf16x8 qa; if constexpr (0 < NQR) qa = qr[0]; else qa = *reinterpret_cast<const LAS bf16x8*>(ql);
        __builtin_amdgcn_sched_group_barrier(0x100, (0 < NQR) ? 2 : 3, 0);
        qk_steps<0>(p0, p1, ka0, ka1, qa, Ks, kb, qr, ql);
    }
    static __device__ __forceinline__ void finishSM8(f32x16& p0, f32x16& p1, float alpha, float& l_reg, i32x8& pf) {
#pragma unroll
        for (int r = 0; r < 16; ++r) p1[r] = __builtin_amdgcn_exp2f(p1[r]);
        float ps = 0;
#pragma unroll
        for (int r = 0; r < 16; ++r) ps += p0[r];
#pragma unroll
        for (int r = 0; r < 16; ++r) ps += p1[r];
        { unsigned xa = __float_as_uint(ps), xb = xa; asm volatile("" : "+v"(xb));
          auto rr = __builtin_amdgcn_permlane32_swap(xa, xb, false, false);
          ps = __uint_as_float(rr[0]) + __uint_as_float(rr[1]); }
        l_reg = l_reg * alpha + ps;
#pragma unroll
        for (int i = 0; i < 4; ++i) { const unsigned x = pk4_f8(p0[4 * i], p0[4 * i + 1], p0[4 * i + 2], p0[4 * i + 3]), y = pk4_f8(p1[4 * i], p1[4 * i + 1], p1[4 * i + 2], p1[4 * i + 3]);
            auto rr = __builtin_amdgcn_permlane32_swap(x, y, false, false); pf[2 * i] = (int)rr[0]; pf[2 * i + 1] = (int)rr[1]; }
    }
    static __device__ __forceinline__ void pv8(f32x16* o, const LAS char* Vs, int vb8_0, int vb8_1, const i32x8& pf) {
#pragma unroll
        for (int d0 = 0; d0 < 4; ++d0) {
            const i32x4 lo = *reinterpret_cast<const LAS i32x4*>(Vs + vb8_0 + d0 * 2048), hi4 = *reinterpret_cast<const LAS i32x4*>(Vs + vb8_1 + d0 * 2048);
            const i32x8 vf = __builtin_shufflevector(lo, hi4, 0, 1, 2, 3, 4, 5, 6, 7);
            o[d0] = __builtin_amdgcn_mfma_scale_f32_32x32x64_f8f6f4(pf, vf, o[d0], 0, 0, 0, 0x7F7F7F7F, 0, 0x7F7F7F7F); }
    }
    static __device__ __forceinline__ void qkt8(f32x16& p0, f32x16& p1, const LAS char* Ks, int kb8_0, int kb8_1, const i32x8 (&q8)[3]) {
        p0 = f32x16{}; p1 = f32x16{};
#pragma unroll
        for (int d0 = 0; d0 < 3; ++d0) {
            const i32x4 a0l = *reinterpret_cast<const LAS i32x4*>(Ks + kb8_0 + d0 * 64), a0h = *reinterpret_cast<const LAS i32x4*>(Ks + kb8_1 + d0 * 64);
            const i32x4 a1l = *reinterpret_cast<const LAS i32x4*>(Ks + kb8_0 + d0 * 64 + 32 * 192), a1h = *reinterpret_cast<const LAS i32x4*>(Ks + kb8_1 + d0 * 64 + 32 * 192);
            const i32x8 a0 = __builtin_shufflevector(a0l, a0h, 0, 1, 2, 3, 4, 5, 6, 7), a1 = __builtin_shufflevector(a1l, a1h, 0, 1, 2, 3, 4, 5, 6, 7);
            p0 = __builtin_amdgcn_mfma_scale_f32_32x32x64_f8f6f4(a0, q8[d0], p0, 0, 0, 0, 0x7F7F7F7F, 0, 0x7F7F7F7F);
            p1 = __builtin_amdgcn_mfma_scale_f32_32x32x64_f8f6f4(a1, q8[d0], p1, 0, 0, 0, 0x7F7F7F7F, 0, 0x7F7F7F7F); }
    }
    struct VF { s16x4 l0, h0, l1, h1, l2, h2, l3, h3; };
    template <int D0> static __device__ __forceinline__ VF v_reads(int vb) {
        VF f; f.l0 = tr_read<v_rd_off(D0, 0, 0)>(vb); f.h0 = tr_read<v_rd_off(D0, 0, 1)>(vb); f.l1 = tr_read<v_rd_off(D0, 1, 0)>(vb); f.h1 = tr_read<v_rd_off(D0, 1, 1)>(vb);
        f.l2 = tr_read<v_rd_off(D0, 2, 0)>(vb); f.h2 = tr_read<v_rd_off(D0, 2, 1)>(vb); f.l3 = tr_read<v_rd_off(D0, 3, 0)>(vb); f.h3 = tr_read<v_rd_off(D0, 3, 1)>(vb); return f; }
    static __device__ __forceinline__ void pv_mma(f32x16& od, const VF& f, bf16x8 pa0, bf16x8 pa1, bf16x8 pa2, bf16x8 pa3) {
#define PK(L, H) (bf16x8){L[0], L[1], L[2], L[3], H[0], H[1], H[2], H[3]}
        od = __builtin_amdgcn_mfma_f32_32x32x16_bf16(pa0, PK(f.l0, f.h0), od, 0, 0, 0);
        od = __builtin_amdgcn_mfma_f32_32x32x16_bf16(pa1, PK(f.l1, f.h1), od, 0, 0, 0);
        od = __builtin_amdgcn_mfma_f32_32x32x16_bf16(pa2, PK(f.l2, f.h2), od, 0, 0, 0);
        od = __builtin_amdgcn_mfma_f32_32x32x16_bf16(pa3, PK(f.l3, f.h3), od, 0, 0, 0);
#undef PK
    }
    static __device__ __forceinline__ void pv_d0(f32x16* o, int vb, bf16x8 pa0, bf16x8 pa1, bf16x8 pa2, bf16x8 pa3) {
        const VF f0 = v_reads<0>(vb); const VF f1 = v_reads<1>(vb);
        asm volatile("s_waitcnt lgkmcnt(8)" ::: "memory"); SBAR();
        pv_mma(o[0], f0, pa0, pa1, pa2, pa3);
        if constexpr (ND0 == 4) {
            SBAR(); const VF f2 = v_reads<2>(vb);
            asm volatile("s_waitcnt lgkmcnt(8)" ::: "memory"); SBAR();
            pv_mma(o[1], f1, pa0, pa1, pa2, pa3);
            SBAR(); const VF f3 = v_reads<3>(vb);
            asm volatile("s_waitcnt lgkmcnt(8)" ::: "memory"); SBAR();
            pv_mma(o[2], f2, pa0, pa1, pa2, pa3);
            asm volatile("s_waitcnt lgkmcnt(0)" ::: "memory"); SBAR();
            pv_mma(o[3], f3, pa0, pa1, pa2, pa3);
        } else {
            asm volatile("s_waitcnt lgkmcnt(0)" ::: "memory"); SBAR();
            pv_mma(o[1], f1, pa0, pa1, pa2, pa3);
        }
    }

    static __device__ __forceinline__ void run(const bf16* Qb, const bf16* Kh, const bf16* Vh, bf16* Ob, int NT, int lrow0, int q0, int lo, float sinkv, LAS unsigned char* ldsu, const int wid  ,
                                              const int qstride = DQK, const float* qg = nullptr, const float* ropec = nullptr, const float* ropes = nullptr, const int qpos0 = 0, const bool qrope = false, const float* mq = nullptr) {
        const int lane = lane_id_now(), tid = wid * 64 + lane, r32 = lane & 31, hi = lane >> 5;
        LAS char* lds = (LAS char*)ldsu; LAS char* V_lds = lds; LAS char* K_lds = lds + 2 * SHM_V;
        LAS float* wsf = (LAS float*)(lds + 2 * SHM_V + 2 * SHM_K) + wid * 64; LAS float* li_l = wsf; LAS float* al_l = wsf + 32;
        int kb[4];
#pragma unroll
        for (int r = 0; r < 4; ++r) kb[r] = r32 * KROW + ((r * 32 + hi * 16) ^ (((r32 >> 1) & 7) << 4));
        float m_reg = -1e30f, l_reg = 0; f32x16 o[ND0]; bf16x8 qr[NQR > 0 ? NQR : 1]; i32x8 q8[3];
        LAS char* ql = lds + QL_OFF + (wid * NQL * 64 + lane) * 16;
        const bf16* Qw = Qb + (long)(wid * 32 + r32) * qstride + hi * 8;
        if constexpr (DQK == 192) {
            const bf16* Qw8 = Qb + (long)(wid * 32 + r32) * qstride + hi * 32;
            u32x4 qv[3][4];
#pragma unroll
            for (int d0 = 0; d0 < 3; ++d0)
#pragma unroll
                for (int c = 0; c < 4; ++c) qv[d0][c] = *(const GAS u32x4*)(Qw8 + d0 * 64 + c * 8);
            float ss = 0.f;
#pragma unroll
            for (int d0 = 0; d0 < 3; ++d0)
#pragma unroll
                for (int c = 0; c < 4; ++c)
#pragma unroll
                    for (int w = 0; w < 4; ++w) { const float a = bflo(qv[d0][c][w]), b = bfhi(qv[d0][c][w]); ss += a * a + b * b; }
            ss += xhalf(ss);
            const f32x2 mqv = *(const GAS f32x2*)(mq + (size_t)(wid * 32 + r32) * 2);
            const float rstd = rsqrtf(ss * (1.f / 192.f) + EPS * ((mqv[0] + mqv[1]) * (1.f / 384.f) + EPS));
            const int qpos = qpos0 + wid * 32 + r32;
#pragma unroll
            for (int d0 = 0; d0 < 3; ++d0) { float v[32];
#pragma unroll
                for (int c = 0; c < 4; ++c) { const f32x4 g0 = *(const GAS f32x4*)(qg + d0 * 64 + hi * 32 + c * 8), g1 = *(const GAS f32x4*)(qg + d0 * 64 + hi * 32 + c * 8 + 4); const u32x4 w = qv[d0][c];
                    v[c * 8 + 0] = bflo(w.x) * rstd * g0[0]; v[c * 8 + 1] = bfhi(w.x) * rstd * g0[1]; v[c * 8 + 2] = bflo(w.y) * rstd * g0[2]; v[c * 8 + 3] = bfhi(w.y) * rstd * g0[3];
                    v[c * 8 + 4] = bflo(w.z) * rstd * g1[0]; v[c * 8 + 5] = bfhi(w.z) * rstd * g1[1]; v[c * 8 + 6] = bflo(w.w) * rstd * g1[2]; v[c * 8 + 7] = bfhi(w.w) * rstd * g1[3]; }
                if (d0 == 2 && qrope) {
#pragma unroll
                    for (int c = 0; c < 4; ++c) { const f32x4 cv = *(const GAS f32x4*)(ropec + qpos * 32 + hi * 16 + c * 4), sv = *(const GAS f32x4*)(ropes + qpos * 32 + hi * 16 + c * 4);
#pragma unroll
                        for (int e = 0; e < 4; ++e) { const float y1 = v[c * 4 + e], y2 = v[16 + c * 4 + e]; v[c * 4 + e] = y1 * cv[e] - y2 * sv[e]; v[16 + c * 4 + e] = y1 * sv[e] + y2 * cv[e]; } } }
#pragma unroll
                for (int k = 0; k < 8; ++k) q8[d0][k] = (int)pk4_f8(v[4 * k], v[4 * k + 1], v[4 * k + 2], v[4 * k + 3]); }
        } else {
#pragma unroll
            for (int d0 = 0; d0 < NQ; ++d0) { const bf16x8 qv = *(const GAS bf16x8*)(Qw + d0 * 16); if (d0 < NQR) qr[d0] = qv; else *reinterpret_cast<LAS bf16x8*>(ql + (d0 - NQR) * 1024) = qv; }
        }
#pragma unroll
        for (int d = 0; d < ND0; ++d) { float z = 0.f; asm volatile("" : "+v"(z)); o[d] = (f32x16){z, z, z, z, z, z, z, z, z, z, z, z, z, z, z, z}; }
        int kg[NKC], kl[NKC], vg[NVC], vl[NVC];
#pragma unroll
        for (int i = 0; i < NKC; ++i) { const int id = tid + 512 * i, row = id / (DQK / 8), c8 = id % (DQK / 8); kg[i] = row * DQK + c8 * 8; kl[i] = kswz(row, c8 * 16); }
#pragma unroll
        for (int i = 0; i < NVC; ++i) { const int id = tid + 512 * i, row = id / (DV / 8), c8 = id % (DV / 8); vg[i] = row * DV + c8 * 8; vl[i] = v_st(row, c8 * 8); }
        unsigned kgd[NKC], vgd[NVC];
#pragma unroll
        for (int i = 0; i < NKC; ++i) { const int id = tid + 512 * i, row = id / (DQK / 8), pos = id % (DQK / 8), c8 = (pos & ~7) | ((pos & 7) ^ ((row >> 1) & 7)); kgd[i] = (unsigned)(row * KROW + c8 * 16); }
        unsigned kgd8[2];
#pragma unroll
        for (int i = 0; i < 2; ++i) { const int id = tid + 512 * i, key = id / 12, pos = id % 12, c = (pos & ~3) | ((pos & 3) ^ ((key >> 2) & 3)); kgd8[i] = (unsigned)(key * 192 + c * 16); }
        const unsigned vgd8 = (unsigned)((tid >> 2) * NKEY + (((tid & 3) ^ ((tid >> 4) & 3)) << 4));
        const int vb8_0 = r32 * 64 + (((hi * 2) ^ ((r32 >> 2) & 3)) << 4), vb8_1 = r32 * 64 + (((hi * 2 + 1) ^ ((r32 >> 2) & 3)) << 4);
        const int ks8 = (r32 >> 2) & 3, kb8_0 = r32 * 192 + (((hi * 2) ^ ks8) << 4), kb8_1 = r32 * 192 + (((hi * 2 + 1) ^ ks8) << 4);
#pragma unroll
        for (int i = 0; i < NVC; ++i) { const int id = tid + 512 * i, sub = id >> 5, w32 = id & 31, kk = (sub / ND0) * 8 + (w32 >> 2), k = (kk & ~0xC) | ((kk & 4) << 1) | ((kk & 8) >> 1), c = (sub % ND0) * 32 + (w32 & 3) * 8;
            vgd[i] = (unsigned)(k * DV * 2 + c * 2); }
        const unsigned ldsw16 = (unsigned)wid * 1024u;
        const int vb0 = (int)(unsigned)(uintptr_t)V_lds + v_rd_base(lane);
        const int drel0 = lo - (q0 + wid * 32 + r32);
        struct { bf16x8 ks[NKC]; bf16x8 vs[NVC]; } sr_[2];
#define TROW(j) ((j) < 4 ? 64 * (j) : lrow0 + 64 * ((j) - 4))
#define SLOAD(i, j) do { const long _r = TROW(j); _Pragma("unroll") for (int _c = 0; _c < NKC; ++_c) sr_[i].ks[_c] = *(const GAS bf16x8*)(Kh + _r * DQK + kg[_c]); \
    _Pragma("unroll") for (int _c = 0; _c < NVC; ++_c) sr_[i].vs[_c] = *(const GAS bf16x8*)(Vh + _r * DV + vg[_c]); } while (0)
#define SWRITE(b, i) do { _Pragma("unroll") for (int _c = 0; _c < NVC; ++_c) *(LAS bf16x8*)(V_lds + (b) * SHM_V + vl[_c]) = sr_[i].vs[_c]; \
    _Pragma("unroll") for (int _c = 0; _c < NKC; ++_c) *(LAS bf16x8*)(K_lds + (b) * SHM_K + kl[_c]) = sr_[i].ks[_c]; } while (0)
#define RESC(a) do { if (__any((a) < 1.f)) { if (hi == 0) al_l[r32] = (a); asm volatile("s_waitcnt lgkmcnt(0)" ::: "memory"); \
    _Pragma("unroll") for (int d = 0; d < ND0; ++d) _Pragma("unroll") for (int r = 0; r < 16; ++r) o[d][r] *= al_l[crow(r, hi)]; } } while (0)
#define DREL(j) (drel0 + 64 * ((j) - 4))
        f32x16 p0, p1; float mn, al; bf16x8 pa0, pa1, pa2, pa3;
        constexpr int S0 = 0, S1 = 1;
#define COMPUTE(j, b) do { SBAR(); if constexpr (DQK == 192) qkt8(p0, p1, K_lds + (b) * SHM_K, kb8_0, kb8_1, q8); else qkt(p0, p1, K_lds + (b) * SHM_K, kb, qr, ql); partialSM(p0, p1, m_reg, mn, al, (j) >= 4, DREL(j), hi); RESC(al); \
    if constexpr (DQK == 192) { i32x8 pf; finishSM8(p0, p1, al, l_reg, pf); SBAR(); pv8(o, V_lds + (b) * SHM_V, vb8_0, vb8_1, pf); } \
    else { finishSM(p0, p1, al, l_reg, pa0, pa1, pa2, pa3); SBAR(); pv_d0(o, vb0 + (b) * SHM_V, pa0, pa1, pa2, pa3); } } while (0)
        if constexpr (DQK > 64) {
#define ADMA(ldsaddr, gbase, voff) asm volatile("s_mov_b32 m0, %0\n\ts_nop 0\n\tglobal_load_lds_dwordx4 %1, %2" :: "s"(ldsaddr), "v"(voff), "s"(gbase) : "memory")
#define TDMA(j, b) do { const char* _gk = (const char*)Kh + (long)TROW(j) * 192; const char* _gv = (const char*)Vh + (long)TROW(j); \
    ADMA((unsigned)(uintptr_t)(K_lds + (b) * SHM_K) + ldsw16, _gk, kgd8[0]); if (wid < 4) ADMA((unsigned)(uintptr_t)(K_lds + (b) * SHM_K + 8192) + ldsw16, _gk, kgd8[1]); \
    ADMA((unsigned)(uintptr_t)(V_lds + (b) * SHM_V) + ldsw16, _gv, vgd8); } while (0)
#define DWAIT() asm volatile("s_waitcnt vmcnt(0)" ::: "memory")
            TDMA(0, 0); DWAIT(); __syncthreads();
            for (int j = 0; j < NT; j += 2) {
                TDMA(j + 1, 1);
                COMPUTE(j, 0);
                DWAIT(); __syncthreads();
                if (j + 2 < NT) TDMA(j + 2, 0);
                COMPUTE(j + 1, 1);
                DWAIT(); __syncthreads();
            }
#undef ADMA
#undef TDMA
#undef DWAIT
        } else {
            SLOAD(S0, 0); asm volatile("s_waitcnt vmcnt(0)" ::: "memory"); SWRITE(0, S0); SLOAD(S1, 1); __syncthreads();
            for (int j = 0; j < NT; j += 2) {
                if (j + 2 < NT) SLOAD(S0, j + 2);
                COMPUTE(j, 0);
                SWRITE(1, S1);
                __syncthreads();
                if (j + 3 < NT) SLOAD(S1, j + 3);
                COMPUTE(j + 1, 1);
                if (j + 2 < NT) SWRITE(0, S0);
                __syncthreads();
            }
        }
#undef COMPUTE
        if (SINK) { constexpr float C = SCALE * 1.4426950408889634f; l_reg += __builtin_amdgcn_exp2f(sinkv * 1.4426950408889634f - m_reg * C); }
        if (hi == 0) li_l[r32] = l_reg; asm volatile("s_waitcnt lgkmcnt(0)" ::: "memory");
        float rli[16];
#pragma unroll
        for (int r = 0; r < 16; ++r) rli[r] = __builtin_amdgcn_rcpf(li_l[crow(r, hi)]);
        unsigned char* Ow = (unsigned char*)Ob + (long)(wid * 32) * 1024;
        if constexpr (NQL * 1024 >= 32 * DV) {
            LAS unsigned char* ot = (LAS unsigned char*)(lds + QL_OFF + wid * NQL * 1024);
#pragma unroll
            for (int r = 0; r < 16; ++r) { const int orow = crow(r, hi);
#pragma unroll
                for (int d0 = 0; d0 < ND0; ++d0) { const float ov = o[d0][r] * rli[r]; ot[orow * DV + d0 * 32 + r32] = (unsigned char)(__builtin_amdgcn_cvt_pk_fp8_f32(ov, ov, 0, false) & 0xff); } }
            asm volatile("s_waitcnt lgkmcnt(0)" ::: "memory");
            constexpr int SEG = DV / 16, LPR = 64 / 32;
            const int orow2 = lane / LPR, seg0 = (lane % LPR) * (SEG / LPR);
#pragma unroll
            for (int i = 0; i < SEG / LPR; ++i) { const u32x4 w = *(const LAS u32x4*)(ot + orow2 * DV + (seg0 + i) * 16); *(GAS u32x4*)(Ow + (long)orow2 * 1024 + (seg0 + i) * 16) = w; }
        } else {
#pragma unroll
        for (int r = 0; r < 16; ++r) { const int orow = crow(r, hi);
#pragma unroll
            for (int d0 = 0; d0 < ND0; ++d0) { const float ov = o[d0][r] * rli[r]; ((GAS unsigned char*)Ow)[(long)orow * 1024 + d0 * 32 + r32] = (unsigned char)(__builtin_amdgcn_cvt_pk_fp8_f32(ov, ov, 0, false) & 0xff); } }
        }
        __syncthreads();
#undef TROW
#undef SLOAD
#undef SWRITE
#undef RESC
#undef DREL
    }
};
}

struct Args {
    const float* in[29];
    float* out; unsigned char* ws;
    int ph_lo, ph_hi;
};
enum { I_X = 0, I_C, I_CTX, I_CCTX, I_N1G, I_N2G, I_WADA, I_BADA, I_WIN, I_QNORM, I_KVNORM, I_WUQ, I_WUKV, I_QHN, I_KHN, I_CONVW, I_CONVB, I_LNG, I_LNB,
       I_SQN, I_SKN, I_SINK, I_WOUT, I_RW, I_RB, I_W1, I_B1, I_W2, I_B2 };

typedef const float* cfp_t;
typedef const __attribute__((address_space(4))) cfp_t* KArgs;
struct Ctx {
    LAS unsigned char* lds; char* ldsg;
    int tid, lane, wave, G, vcu, gw, NGW;
    unsigned char* ws; KArgs in; float* out;
};
#define WSP(T, off) ((T*)(C.ws + (off)))

__device__ __forceinline__ void tok_info(int t, int& b, bool& isctx, int& pos, int& key) {
    if (t < TL) { b = t >> 11; pos = t & 2047; isctx = false; key = NCTX + pos; } else { const int tc = t - TL; b = tc >> 8; pos = tc & 255; isctx = true; key = pos; }
}

constexpr int NP_CQ = 256, NP_KROPE = 640, NP_PAD = 704;
__host__ __device__ constexpr int win_dstblk(int nb) { return nb < 4 ? nb : nb == 4 ? 10 : nb < 9 ? nb + 7 : nb < 15 ? nb - 5 : nb < 21 ? nb + 1 : nb < 23 ? nb + 3 : nb < 25 ? nb - 1 : nb + 1; }
__device__ __forceinline__ void cvt_item(const float* W, int K, int N, bf16* WT, int item, int lane, bool w1perm, LAS unsigned char* scr  , const float* kscale = nullptr  , const bool winperm = false) {
    const int nblk = N / 64, kb = item / nblk, nb = item - kb * nblk, k0 = 64 * kb, n0 = 64 * nb;
    const float* src = W + (size_t)k0 * N + n0 + lane;
    float v[64];
#pragma unroll
    for (int i = 0; i < 64; ++i) v[i] = __builtin_nontemporal_load(src + (size_t)i * N);
    if (kscale) {
#pragma unroll
        for (int i = 0; i < 64; ++i) v[i] *= kscale[k0 + i]; }
#pragma unroll
    for (int c = 0; c < 8; ++c) { u32x4 o; o.x = pk2(v[8 * c], v[8 * c + 1]); o.y = pk2(v[8 * c + 2], v[8 * c + 3]); o.z = pk2(v[8 * c + 4], v[8 * c + 5]); o.w = pk2(v[8 * c + 6], v[8 * c + 7]);
        *(LAS u32x4*)(scr + lane * 144 + c * 16) = o; }
    asm volatile("s_waitcnt lgkmcnt(0)" ::: "memory");
#pragma unroll
    for (int j = 0; j < 8; ++j) { const int row = j * 8 + (lane >> 3), ch = lane & 7, n = n0 + row;
        const int nd = w1perm ? (256 * (n >> 8) + 128 * (n & 1) + ((n >> 1) & 127)) : winperm ? (64 * win_dstblk(nb) + row) : n;
        const u32x4 o = *(const LAS u32x4*)(scr + row * 144 + ch * 16);
        *(GAS u32x4*)(WT + (size_t)nd * K + k0 + ch * 8) = o; }
    asm volatile("s_waitcnt lgkmcnt(0)" ::: "memory");
}
constexpr float YK_SCALE = 32.f;
constexpr float F8_WSCALE = 1024.f;
__device__ __forceinline__ void cvt_item_f8(const float* W, int K, int N, unsigned char* WT, int item, int lane, bool w1perm, LAS unsigned char* scr, const bool winperm = false) {
    const int nblk = N / 64, kb = item / nblk, nb = item - kb * nblk, k0 = 64 * kb, n0 = 64 * nb;
    const float* src = W + (size_t)k0 * N + n0 + lane;
    float v[64];
#pragma unroll
    for (int i = 0; i < 64; ++i) v[i] = __builtin_nontemporal_load(src + (size_t)i * N) * F8_WSCALE;
#pragma unroll
    for (int c = 0; c < 4; ++c) { u32x4 o; o.x = pk4_f8(v[16 * c], v[16 * c + 1], v[16 * c + 2], v[16 * c + 3]); o.y = pk4_f8(v[16 * c + 4], v[16 * c + 5], v[16 * c + 6], v[16 * c + 7]);
        o.z = pk4_f8(v[16 * c + 8], v[16 * c + 9], v[16 * c + 10], v[16 * c + 11]); o.w = pk4_f8(v[16 * c + 12], v[16 * c + 13], v[16 * c + 14], v[16 * c + 15]);
        *(LAS u32x4*)(scr + lane * 80 + c * 16) = o; }
    asm volatile("s_waitcnt lgkmcnt(0)" ::: "memory");
#pragma unroll
    for (int j = 0; j < 4; ++j) { const int row = j * 16 + (lane >> 2), ch = lane & 3, n = n0 + row;
        const int nd = w1perm ? (256 * (n >> 8) + 128 * (n & 1) + ((n >> 1) & 127)) : winperm ? (64 * win_dstblk(nb) + row) : n;
        const u32x4 o = *(const LAS u32x4*)(scr + row * 80 + ch * 16);
        *(GAS u32x4*)(WT + (size_t)nd * K + k0 + ch * 16) = o; }
    asm volatile("s_waitcnt lgkmcnt(0)" ::: "memory");
}
constexpr int CVT_I_IN = 16 * 27, CVT_I_KV = 4 * 16, CVT_I_Q = 6 * 12, CVT_I_O = 16 * 16, CVT_I_1 = 32 * 16 * 32, CVT_I_2 = 32 * 16 * 16, CVT_ITEMS = CVT_I_IN + CVT_I_KV + CVT_I_Q + CVT_I_O + CVT_I_1 + CVT_I_2;
__device__ __forceinline__ void cvt_layer_item(Ctx& C, int l, int r) {
    unsigned char* wb = C.ws + WS_W + (size_t)l * WB_LAYER; LAS unsigned char* scr = C.lds + C.wave * 9216;
    if (r < CVT_I_IN) { cvt_item_f8(C.in[I_WIN] + (size_t)l * 1024 * INC, 1024, INC, (unsigned char*)(wb + WB_IN), r, C.lane, false, scr, true); return; } r -= CVT_I_IN;
    if (r < CVT_I_KV) { cvt_item(C.in[I_WUKV] + (size_t)l * 256 * 1024, 256, 1024, (bf16*)(wb + WB_UKV), r, C.lane, false, scr); return; } r -= CVT_I_KV;
    if (r < CVT_I_Q) { cvt_item(C.in[I_WUQ] + (size_t)l * 384 * 768, 384, 768, (bf16*)(wb + WB_UQ), r, C.lane, false, scr, C.in[I_QNORM] + l * 384); return; } r -= CVT_I_Q;
    if (r < CVT_I_O) { cvt_item_f8(C.in[I_WOUT] + (size_t)l * 1024 * 1024, 1024, 1024, (unsigned char*)(wb + WB_OUT), r, C.lane, false, scr); return; } r -= CVT_I_O;
    if (r < CVT_I_1) { const int e = r / 512, ri = r % 512; cvt_item_f8(C.in[I_W1] + ((size_t)l * NE + e) * 1024 * 2048, 1024, 2048, (unsigned char*)(wb + WB_W1) + (size_t)e * 2048 * 1024, ri, C.lane, true, scr); return; } r -= CVT_I_1;
    { const int e = r / 256, ri = r % 256; cvt_item_f8(C.in[I_W2] + ((size_t)l * NE + e) * 1024 * 1024, 1024, 1024, (unsigned char*)(wb + WB_W2) + (size_t)e * 1024 * 1024, ri, C.lane, false, scr); }
}
constexpr int CVT_Q6 = 6, CVT_Q7 = 4, CVT_Q9 = 2, CVT_Q10 = 2;
__device__ __forceinline__ void cvt_static(Ctx& C, int base, int j, int nj, int q) {
    for (int k = 0; k < q; ++k) { const int it = base + k * nj + j; if (it < CVT_ITEMS) cvt_layer_item(C, 1, it); }
}
__device__ __forceinline__ int cvt_n6() { return 224 * NWAVES * CVT_Q6; }
__device__ __forceinline__ int cvt_n7() { return 224 * NWAVES * CVT_Q7; }
__device__ __forceinline__ int cvt_idle(int nwg, int G) { const int rem = nwg % G; return rem ? G - rem : 0; }
__device__ __forceinline__ void p0_prologue(Ctx& C) {
    if (C.vcu < 192) {
        const int l = C.vcu / 96, c0 = (C.vcu % 96) * 64;
        float* s = (float*)C.ldsg;
        float* part = (float*)(C.ldsg + 49152);
        const float* cin = C.in[I_C]; const float* cctx = C.in[I_CCTX];
        for (int i = C.tid; i < 9 * 1024; i += NTHREADS) { const int r = i >> 10, k = i & 1023; const float c = r < 8 ? cin[r * 1024 + k] : cctx[k]; s[k * 12 + r] = c / (1.f + __expf(-c)); }
        __syncthreads();
        const int col = C.tid & 63, kg = C.tid >> 6;
        const float* W = C.in[I_WADA] + (size_t)l * 1024 * 6144 + c0 + col;
        float acc[9];
#pragma unroll
        for (int r = 0; r < 9; ++r) acc[r] = 0.f;
#pragma unroll 16
        for (int kk = 0; kk < 128; ++kk) { const int k = kg * 128 + kk; const float w = W[(size_t)k * 6144];
            const f32x4 s0 = *(const f32x4*)&s[k * 12], s1 = *(const f32x4*)&s[k * 12 + 4]; const float s2 = s[k * 12 + 8];
            acc[0] += w * s0[0]; acc[1] += w * s0[1]; acc[2] += w * s0[2]; acc[3] += w * s0[3]; acc[4] += w * s1[0]; acc[5] += w * s1[1]; acc[6] += w * s1[2]; acc[7] += w * s1[3]; acc[8] += w * s2; }
#pragma unroll
        for (int r = 0; r < 9; ++r) part[(kg * 9 + r) * 64 + col] = acc[r];
        __syncthreads();
        float* ada = WSP(float, WS_ADA);
        for (int i = C.tid; i < 9 * 64; i += NTHREADS) { const int r = i >> 6, c = i & 63; float a = C.in[I_BADA][l * 6144 + c0 + c];
#pragma unroll
            for (int g = 0; g < 8; ++g) a += part[(g * 9 + r) * 64 + c];
            ada[(size_t)(l * 9 + r) * 6144 + c0 + c] = a; }
        __syncthreads();
    }
    {
        float* ct = WSP(float, WS_ROPE); float* st = ct + 2048 * 32;
        for (int i = C.vcu * NTHREADS + C.tid; i < 2048 * 32; i += C.G * NTHREADS) { const int n = i >> 5, a = (i >> 4) & 1, j = i & 15;
            const float pos = (float)(a ? (n & 63) : (n >> 6)); const float inv = powf(10000.f, -(float)j / 16.f); const float ang = pos * inv;
            ct[i] = cosf(ang); st[i] = sinf(ang); }
    }
    {
        constexpr int CVT_PX = 3, CVT_X0 = 512 * CVT_PX;
        const bool early = C.vcu >= 192; const int gwx = (C.vcu - 192) * NWAVES + C.wave;
        for (int k = 0; ; ++k) { const int it = early ? (k < CVT_PX ? gwx + k * 512 : CVT_X0 + C.gw + (k - CVT_PX) * C.NGW) : CVT_X0 + C.gw + k * C.NGW;
            if (it >= CVT_ITEMS) break; cvt_layer_item(C, 0, it); }
        for (int l = 0; l < NLAYER; ++l) { u32x4* z = (u32x4*)(C.ws + WS_W + (size_t)l * WB_LAYER + WB_IN + (size_t)NP_PAD * 1024);
            unsigned zz = 0u; asm volatile("" : "+v"(zz));
            for (int i = C.vcu * NTHREADS + C.tid; i < 64 * 1024 / 16; i += C.G * NTHREADS) z[i] = (u32x4){zz, zz, zz, zz}; }
    }
}

template <int TP> __device__ __forceinline__ void norm1_phase_t(Ctx& C, int l) {
    const float* ada = WSP(float, WS_ADA); bf16* H = WSP(bf16, WS_H); const bf16* YK = WSP(bf16, WS_YK);
    const float* ng = C.in[I_N1G] + l * 1024; const int lane = C.lane;
    constexpr int CH = 9; static_assert(NTOK % CH == 0 && CH % TP == 0, "token chunking");
    f32x4 ga[4], sf[4], g2s[4]; int rc;
#define N1_MOD(R) do { const float* sh_ = ada + (size_t)(l * 9 + (R)) * 6144; const float* sc_ = sh_ + 1024; \
        _Pragma("unroll") for (int j = 0; j < 4; ++j) { const f32x4 g_ = *((const GAS f32x4*)ng + lane + 64 * j), a_ = *((const GAS f32x4*)sc_ + lane + 64 * j); \
            sf[j] = *((const GAS f32x4*)sh_ + lane + 64 * j); ga[j] = g_ * (a_ + 1.f); \
            if (l > 0) g2s[j] = *((const GAS f32x4*)(ada + (size_t)((l - 1) * 9 + (R)) * 6144 + 5 * 1024) + lane + 64 * j) * (1.f / YK_SCALE); else g2s[j] = (f32x4){0.f, 0.f, 0.f, 0.f}; } } while (0)
    { const int tf = C.gw * CH; rc = __builtin_amdgcn_readfirstlane(tf >= TL ? 8 : (tf >> 11)); if (tf < NTOK) N1_MOD(rc); }
    for (int tc = C.gw * CH; tc < NTOK; tc += C.NGW * CH)
    for (int t0 = tc; t0 < tc + CH; t0 += TP) {
        f32x4 v[TP][4]; unsigned yk[TP][4][4];
#pragma unroll
        for (int i = 0; i < TP; ++i) { const int t = t0 + i; const bool isctx = t >= TL;
            if (l == 0) { const float* xin = isctx ? C.in[I_CTX] + (size_t)(t - TL) * DM : C.in[I_X] + (size_t)t * DM;
#pragma unroll
                for (int j = 0; j < 4; ++j) v[i][j] = *((const GAS f32x4*)xin + lane + 64 * j); }
            else { const bf16* xin = WSP(bf16, WS_XS) + (size_t)t * DM;
#pragma unroll
                for (int j = 0; j < 4; ++j) { const u32x2 w = *((const GAS u32x2*)xin + lane + 64 * j); v[i][j] = (f32x4){bflo(w.x), bfhi(w.x), bflo(w.y), bfhi(w.y)}; } }
            if (l > 0) {
#pragma unroll
                for (int j = 0; j < 4; ++j)
#pragma unroll
                    for (int k = 0; k < 4; ++k) yk[i][j][k] = *((const GAS unsigned*)((const unsigned char*)YK + (size_t)(t * 4 + k) * 1024) + lane + 64 * j); } }
#pragma unroll
        for (int i = 0; i < TP; ++i) { const int t = t0 + i; const bool isctx = t >= TL; const int r = __builtin_amdgcn_readfirstlane(isctx ? 8 : (t >> 11));
            if (r != rc) { rc = r; N1_MOD(r); }
            if (l > 0) { bf16* xst = WSP(bf16, WS_XS) + (size_t)t * DM;
#pragma unroll
                for (int j = 0; j < 4; ++j) { f32x4 y = (f32x4){0.f, 0.f, 0.f, 0.f};
#pragma unroll
                    for (int k = 0; k < 4; ++k) { const unsigned w = yk[i][j][k]; const f32x2 lo = __builtin_amdgcn_cvt_pk_f32_fp8((int)w, false), hi = __builtin_amdgcn_cvt_pk_f32_fp8((int)w, true); y[0] += lo[0]; y[1] += lo[1]; y[2] += hi[0]; y[3] += hi[1]; }
                    v[i][j] = v[i][j] + g2s[j] * y;
                    u32x2 xw; xw.x = cvt_pk_bf16(v[i][j][0], v[i][j][1]); xw.y = cvt_pk_bf16(v[i][j][2], v[i][j][3]); *((GAS u32x2*)xst + lane + 64 * j) = xw;
                    v[i][j] = (f32x4){bflo(xw.x), bfhi(xw.x), bflo(xw.y), bfhi(xw.y)}; } }
            float ss = 0.f;
#pragma unroll
            for (int j = 0; j < 4; ++j) ss += (v[i][j][0] * v[i][j][0] + v[i][j][1] * v[i][j][1]) + (v[i][j][2] * v[i][j][2] + v[i][j][3] * v[i][j][3]);
            const float rstd = rsqrtf(wave_sum(ss) * (1.f / DM) + EPS);
#pragma unroll
            for (int j = 0; j < 4; ++j) {
                const f32x4 h = v[i][j] * rstd * ga[j] + sf[j]; *((GAS unsigned*)((unsigned char*)H + (size_t)t * DM) + lane + 64 * j) = pk4_f8(h[0], h[1], h[2], h[3]); } }
    }
}
#undef N1_MOD
__device__ __forceinline__ void norm1_phase(Ctx& C, int l) { if (l == 0) norm1_phase_t<3>(C, 0); else norm1_phase_t<3>(C, l); }
__device__ __forceinline__ void final_phase(Ctx& C) {
    const float* ada = WSP(float, WS_ADA); const bf16* YK = WSP(bf16, WS_YK); const int lane = C.lane;
    constexpr int TP = 4, CH = 8; static_assert(2048 % CH == 0 && CH % TP == 0 && TL % CH == 0, "token chunking");
    for (int tc = C.gw * CH; tc < TL; tc += C.NGW * CH) {
    f32x4 g2s[4];
    { const float* g2 = ada + (size_t)(9 + (tc >> 11)) * 6144 + 5 * 1024;
#pragma unroll
      for (int j = 0; j < 4; ++j) g2s[j] = *((const GAS f32x4*)g2 + lane + 64 * j) * (1.f / YK_SCALE); }
    for (int t0 = tc; t0 < tc + CH; t0 += TP) {
        f32x4 x[TP][4]; unsigned yk[TP][4][4];
#pragma unroll
        for (int i = 0; i < TP; ++i) { const int t = t0 + i;
#pragma unroll
            for (int j = 0; j < 4; ++j) { { const u32x2 w = *((const GAS u32x2*)(WSP(bf16, WS_XS) + (size_t)t * DM) + lane + 64 * j); x[i][j] = (f32x4){bflo(w.x), bfhi(w.x), bflo(w.y), bfhi(w.y)}; }
#pragma unroll
                for (int k = 0; k < 4; ++k) yk[i][j][k] = *((const GAS unsigned*)((const unsigned char*)YK + (size_t)(t * 4 + k) * 1024) + lane + 64 * j); } }
#pragma unroll
        for (int i = 0; i < TP; ++i) { const int t = t0 + i;
#pragma unroll
            for (int j = 0; j < 4; ++j) { f32x4 y = (f32x4){0.f, 0.f, 0.f, 0.f};
#pragma unroll
                for (int k = 0; k < 4; ++k) { const unsigned w = yk[i][j][k]; const f32x2 lo = __builtin_amdgcn_cvt_pk_f32_fp8((int)w, false), hi = __builtin_amdgcn_cvt_pk_f32_fp8((int)w, true); y[0] += lo[0]; y[1] += lo[1]; y[2] += hi[0]; y[3] += hi[1]; }
                *((GAS f32x4*)(C.out + (size_t)t * DM) + lane + 64 * j) = x[i][j] + g2s[j] * y; } }
    } }
}

__device__ __forceinline__ f32x4 rope4(f32x4 v, const float* ct, const float* st, int n, int lane) {
    const int a = (lane & 15) >> 3, half = (lane & 7) >> 2, j0 = 4 * (lane & 3);
    const f32x4 c = *(const f32x4*)(ct + n * 32 + a * 16 + j0), s = *(const f32x4*)(st + n * 32 + a * 16 + j0);
    f32x4 o; o[0] = swz_xor<4>(v[0]); o[1] = swz_xor<4>(v[1]); o[2] = swz_xor<4>(v[2]); o[3] = swz_xor<4>(v[3]);
    return half ? (o * s + v * c) : (v * c - o * s);
}
__device__ __forceinline__ f32x2 rope2(f32x2 v, const float* ct, const float* st, int n, int lane) {
    const int l5 = lane & 31, a = l5 >> 4, half = (l5 & 15) >> 3, j0 = 2 * (l5 & 7);
    const f32x2 c = *(const f32x2*)(ct + n * 32 + a * 16 + j0), s = *(const f32x2*)(st + n * 32 + a * 16 + j0);
    f32x2 o; o[0] = swz_xor<8>(v[0]); o[1] = swz_xor<8>(v[1]);
    return half ? (o * s + v * c) : (v * c - o * s);
}
template <int TP> __device__ __forceinline__ void post_phase_t(Ctx& C, int l) {
    const bf16* P = WSP(bf16, WS_P); const float* ct = WSP(float, WS_ROPE); const float* st = ct + 2048 * 32;
    bf16* CKVN = WSP(bf16, WS_CKVN); float* MQ = WSP(float, WS_MQ); bf16* SK = WSP(bf16, WS_SK); bf16* SV = WSP(bf16, WS_SV); bf16* SQ = WSP(bf16, WS_SQ); bf16* U = WSP(bf16, WS_U);
    const int lane = C.lane; const bool last = (l == NLAYER - 1);
    const f32x4 gkv = *((const f32x4*)(C.in[I_KVNORM] + l * 256) + lane), gq = *((const f32x4*)(C.in[I_QNORM] + l * 384) + lane);
    const f32x2 gq2 = *((const f32x2*)(C.in[I_QNORM] + l * 384 + 256) + lane);
    const f32x4 gsk = *((const f32x4*)(C.in[I_SKN] + l * 64) + (lane & 15)), gsq = *((const f32x4*)(C.in[I_SQN] + l * 64) + (lane & 15));
    for (int t0 = C.gw * TP; t0 < NTOK; t0 += C.NGW * TP) {
        u32x2 wkv[TP], wsk[TP], wcq[TP], wsq[TP], wa[TP], wg[TP]; unsigned wcq2[TP];
#pragma unroll
        for (int i = 0; i < TP; ++i) { const int t = t0 + i; const bf16* pr = P + (size_t)t * INP; const bool full = !(last && t >= TL);
            wkv[i] = *((const u32x2*)pr + lane); wsk[i] = *((const u32x2*)(pr + O_SK) + lane);
            if (full) { wcq[i] = *((const u32x2*)(pr + O_CQ) + lane); wcq2[i] = *((const unsigned*)(pr + O_CQ + 256) + lane); wsq[i] = *((const u32x2*)(pr + O_SQ) + lane);
                wa[i] = *((const u32x2*)(pr + O_GLU) + lane); wg[i] = *((const u32x2*)(pr + O_GLU + 256) + lane); }
            else { wcq[i] = wsq[i] = wa[i] = wg[i] = (u32x2){0u, 0u}; wcq2[i] = 0u; } }
#pragma unroll
        for (int i = 0; i < TP; ++i) { const int t = t0 + i; int b, pos, key; bool isctx; tok_info(t, b, isctx, pos, key);
            {
                const u32x2 w = wkv[i]; f32x4 v = {bflo(w.x), bfhi(w.x), bflo(w.y), bfhi(w.y)};
                const float rstd = rsqrtf(wave_sum((v[0] * v[0] + v[1] * v[1]) + (v[2] * v[2] + v[3] * v[3])) * (1.f / 256.f) + EPS);
                v = v * rstd * gkv; u32x2 o; o.x = pk2(v[0], v[1]); o.y = pk2(v[2], v[3]); *((u32x2*)(CKVN + (size_t)t * 256) + lane) = o; }
            {
                const u32x2 w = wsk[i]; f32x4 v = {bflo(w.x), bfhi(w.x), bflo(w.y), bfhi(w.y)};
                const float ssh = grp16_sum((v[0] * v[0] + v[1] * v[1]) + (v[2] * v[2] + v[3] * v[3]));
                f32x4 kn = v * rsqrtf(ssh * (1.f / 64.f) + EPS) * gsk;
                const f32x4 kr = rope4(kn, ct, st, isctx ? 0 : pos, lane);
                if (!isctx) kn = kr;
                const int head = (lane >> 4) & 1; const size_t off = ((size_t)(b * 2 + head) * NKEY + key) * 64 + 4 * (lane & 15);
                u32x2 o; if (lane < 32) { o.x = pk2(kn[0], kn[1]); o.y = pk2(kn[2], kn[3]); *(u32x2*)(SK + off) = o; } else { *(u32x2*)(SV + off) = w; } }
            if (!(last && isctx)) {
                {
                    const u32x2 w = wcq[i]; const unsigned w2 = wcq2[i];
                    f32x4 v = {bflo(w.x), bfhi(w.x), bflo(w.y), bfhi(w.y)}; f32x2 v2 = {bflo(w2), bfhi(w2)};
                    const float ssq = wave_sum((v[0] * v[0] + v[1] * v[1]) + (v[2] * v[2] + v[3] * v[3]) + (v2[0] * v2[0] + v2[1] * v2[1]));
                    if (lane == 0) { *(f32x2*)(MQ + (size_t)t * 2) = (f32x2){ssq, 0.f}; } }
                {
                    const u32x2 w = wsq[i]; f32x4 v = {bflo(w.x), bfhi(w.x), bflo(w.y), bfhi(w.y)};
                    const float ssh = grp16_sum((v[0] * v[0] + v[1] * v[1]) + (v[2] * v[2] + v[3] * v[3]));
                    f32x4 qn = v * rsqrtf(ssh * (1.f / 64.f) + EPS) * gsq;
                    const f32x4 qr = rope4(qn, ct, st, isctx ? 0 : pos, lane);
                    if (!isctx) qn = qr;
                    const int head = lane >> 4;
                    const size_t off = isctx ? ((size_t)32 * SEQ * 64 + ((size_t)(b * 4 + head) * NCTX + pos) * 64) : (((size_t)(b * 4 + head) * SEQ + pos) * 64);
                    u32x2 o; o.x = pk2(qn[0], qn[1]); o.y = pk2(qn[2], qn[3]); *(u32x2*)(SQ + off + 4 * (lane & 15)) = o; }
                {
                    const u32x2 xa = wa[i], xg = wg[i];
                    const float u0 = bflo(xa.x) * sigmoidf_(bflo(xg.x)), u1 = bfhi(xa.x) * sigmoidf_(bfhi(xg.x)), u2 = bflo(xa.y) * sigmoidf_(bflo(xg.y)), u3 = bfhi(xa.y) * sigmoidf_(bfhi(xg.y));
                    u32x2 o; o.x = pk2(u0, u1); o.y = pk2(u2, u3); *((u32x2*)(U + (size_t)t * 256) + lane) = o; }
            } }
    }
}
__device__ __forceinline__ void post_phase(Ctx& C, int l) { post_phase_t<3>(C, l); }

template <int TP> __device__ __forceinline__ void finalqk_phase_t(Ctx& C, int l) {
    const bf16* P = WSP(bf16, WS_P); const bf16* KRAW = WSP(bf16, WS_KRAW); const bf16* QRAW = WSP(bf16, WS_QRAW); bf16* KM = WSP(bf16, WS_KMLA); bf16* QM = WSP(bf16, WS_QMLA);
    const float* ct = WSP(float, WS_ROPE); const float* st = ct + 2048 * 32;
    const float* khg = C.in[I_KHN] + l * 192; const float* qhg = C.in[I_QHN] + l * 192;
    const int lane = C.lane, h = lane >> 4, c = lane & 15; const bool last = (l == NLAYER - 1);
    const f32x4 kg0 = *(const f32x4*)(khg + 8 * c), kg1 = *(const f32x4*)(khg + 8 * c + 4), kgp = *(const f32x4*)(khg + 128 + 4 * c);
    const f32x4 qg0 = *(const f32x4*)(qhg + 8 * c), qg1 = *(const f32x4*)(qhg + 8 * c + 4), qgp = *(const f32x4*)(qhg + 128 + 4 * c);
    for (int t0 = C.gw * TP; t0 < NTOK; t0 += C.NGW * TP) {
        u32x4 kn[TP]; u32x2 kp[TP];
#pragma unroll
        for (int i = 0; i < TP; ++i) { const int t = t0 + i;
            kn[i] = *(const u32x4*)(KRAW + (size_t)t * 512 + h * 128 + 8 * c); kp[i] = *(const u32x2*)(P + (size_t)t * INP + O_KROPE + 4 * c); }
#pragma unroll
        for (int i = 0; i < TP; ++i) { const int t = t0 + i; int b, pos, key; bool isctx; tok_info(t, b, isctx, pos, key); const int rn = isctx ? 0 : pos;
            { f32x4 a0 = {bflo(kn[i].x), bfhi(kn[i].x), bflo(kn[i].y), bfhi(kn[i].y)}, a1 = {bflo(kn[i].z), bfhi(kn[i].z), bflo(kn[i].w), bfhi(kn[i].w)}, pe = {bflo(kp[i].x), bfhi(kp[i].x), bflo(kp[i].y), bfhi(kp[i].y)};
              const float ss = row16_sum(((a0[0] * a0[0] + a0[1] * a0[1]) + (a0[2] * a0[2] + a0[3] * a0[3])) + ((a1[0] * a1[0] + a1[1] * a1[1]) + (a1[2] * a1[2] + a1[3] * a1[3])) + ((pe[0] * pe[0] + pe[1] * pe[1]) + (pe[2] * pe[2] + pe[3] * pe[3])));
              const float rstd = rsqrtf(ss * (1.f / 192.f) + EPS);
              a0 = a0 * rstd * kg0; a1 = a1 * rstd * kg1; pe = pe * rstd * kgp;
              const f32x4 per = rope4(pe, ct, st, rn, lane); if (!isctx) pe = per;
              bf16* dst = KM + ((size_t)(b * 4 + h) * NKEY + key) * 192;
              u32x4 w; w.x = pk2(a0[0], a0[1]); w.y = pk2(a0[2], a0[3]); w.z = pk2(a1[0], a1[1]); w.w = pk2(a1[2], a1[3]); *(u32x4*)(dst + 8 * c) = w;
              u32x2 w2; w2.x = pk2(pe[0], pe[1]); w2.y = pk2(pe[2], pe[3]); *(u32x2*)(dst + 128 + 4 * c) = w2; }
        }
    }
}
__device__ __forceinline__ void finalqk_phase(Ctx& C, int l) { finalqk_phase_t<3>(C, l); }

template <int RR> __device__ __forceinline__ void conv_taps(float (&acc)[32], const float (&w)[31], const LAS bf16* ubp) {
    if constexpr (RR < 62) {
        const float u = __builtin_bit_cast(float, (unsigned)ubp[RR * 256] << 16);
        constexpr int o_lo = RR > 30 ? RR - 30 : 0, o_hi = RR < 31 ? RR : 31;
#pragma unroll
        for (int o = o_lo; o <= o_hi; ++o) acc[o] += u * w[RR - o];
        conv_taps<RR + 1>(acc, w, ubp);
    }
}
__device__ __forceinline__ void conv_unit(Ctx& C, int l, int tb  , int L  , int n0) {
    const bf16* U = WSP(bf16, WS_U); unsigned char* CAT = (unsigned char*)WSP(bf16, WS_CAT);
    const int lane = lane_id_now(), wave = C.wave, tid = wave * 64 + lane;
    LAS bf16* ub = (LAS bf16*)C.lds;
    LAS float* Y = (LAS float*)(C.lds + 49152);
    const int c = tid & 255, hf = tid >> 8;
    u32x4 stg[6];
#pragma unroll
    for (int k = 0; k < 6; ++k) { const int i = tid + k * NTHREADS, row = i >> 5, ch = i & 31, n = n0 - 15 + row;
        stg[k] = (u32x4){0u, 0u, 0u, 0u}; if (i < 94 * 32 && n >= 0 && n < L) stg[k] = *((const GAS u32x4*)(U + (size_t)(tb + n) * 256) + ch); }
    const float* cw = C.in[I_CONVW] + (size_t)l * 31 * 256 + c;
    float w[31];
#pragma unroll
    for (int j = 0; j < 31; ++j) w[j] = cw[j * 256];
    const float bias = C.in[I_CONVB][l * 256 + c];
#pragma unroll
    for (int k = 0; k < 6; ++k) { const int i = tid + k * NTHREADS; if (i < 94 * 32) *((LAS u32x4*)ub + i) = stg[k]; }
    __syncthreads();
    {
        float acc[32];
#pragma unroll
        for (int o = 0; o < 32; ++o) acc[o] = bias;
        conv_taps<0>(acc, w, ub + (32 * hf) * 256 + c);
#pragma unroll
        for (int o = 0; o < 32; ++o) Y[(32 * hf + o) * 256 + c] = acc[o];
    }
    __syncthreads();
    {
        const f32x4 g = *((const f32x4*)(C.in[I_LNG] + l * 256) + lane), bb = *((const f32x4*)(C.in[I_LNB] + l * 256) + lane);
#pragma unroll
        for (int i = 0; i < 8; ++i) { const int o = wave * 8 + i; f32x4 y = *((const LAS f32x4*)(Y + o * 256) + lane);
            const float mean = wave_sum((y[0] + y[1]) + (y[2] + y[3])) * (1.f / 256.f); y = y - mean;
            const float var = wave_sum((y[0] * y[0] + y[1] * y[1]) + (y[2] * y[2] + y[3] * y[3])) * (1.f / 256.f);
            y = y * rsqrtf(var + EPS) * g + bb;
            *((GAS unsigned*)(CAT + (size_t)(tb + n0 + o) * DM + 512) + lane) = pk4_f8(y[0] * sigmoidf_(y[0]), y[1] * sigmoidf_(y[1]), y[2] * sigmoidf_(y[2]), y[3] * sigmoidf_(y[3])); }
    }
    __syncthreads();
}

__device__ __forceinline__ void attn_phase(Ctx& C, int l) {
    const bf16* KM = WSP(bf16, WS_KMLA); const bf16* VM = WSP(bf16, WS_VMLA); const bf16* QRAW = WSP(bf16, WS_QRAW);
    const bf16* SK = WSP(bf16, WS_SK); const bf16* SV = WSP(bf16, WS_SV); const bf16* SQ = WSP(bf16, WS_SQ); unsigned char* CAT = (unsigned char*)WSP(bf16, WS_CAT);
    using MLA = att::Body<192, 128, false, false>; using SWA = att::Body<64, 64, true, true>; using SWAC = att::Body<64, 64, false, true>;
    static_assert(MLA::LDS_NEED <= RING_BYTES, "lds");
    const bool first = (l == 0);
    for (int u = C.vcu; u < 256; u += C.G) {
        const int bh = u >> 3, qb = u & 7, b = bh >> 2, h = bh & 3;
#ifndef DBG_REP_ATT
#define DBG_REP_ATT 0
#endif
        for (int rp = 0; rp < ((DBG_REP_ATT & 1) ? 2 : 1); ++rp)
#if !defined(ATT_PART) || (ATT_PART & 1)
        MLA::run(QRAW + (size_t)(b * SEQ + qb * 256) * 768 + h * 192, (const bf16*)((const unsigned char*)KM + (size_t)bh * NKEY * 192), (const bf16*)((const unsigned char*)VM + (size_t)bh * 128 * NKEY), (bf16*)(CAT + (size_t)(b * SEQ + qb * 256) * DM + h * 128), NKEY / 64, 256, 0, 0, 0.f, C.lds, C.wave,
                 768, C.in[I_QHN] + l * 192, WSP(float, WS_ROPE), WSP(float, WS_ROPE) + 2048 * 32, qb * 256, true, WSP(float, WS_MQ) + (size_t)(b * SEQ + qb * 256) * 2);
#endif
#if !defined(ATT_PART) || (ATT_PART & 2)
        for (int rp = 0; rp < ((DBG_REP_ATT & 2) ? 2 : 1); ++rp)
        { const int q0 = qb * 256, lo = q0 - 128 < 0 ? 0 : q0 - 128, hiK = q0 + 384 > SEQ ? SEQ : q0 + 384; const int kvh = b * 2 + (h >> 1);
          SWA::run(SQ + ((size_t)bh * SEQ + q0) * 64, SK + (size_t)kvh * NKEY * 64, SV + (size_t)kvh * NKEY * 64, (bf16*)(CAT + (size_t)(b * SEQ + q0) * DM + 768 + h * 64), 4 + (hiK - lo) / 64, NCTX + lo, q0, lo, C.in[I_SINK][l * 4 + h], C.lds, C.wave); }
#endif
#if !defined(ATT_PART) || (ATT_PART & 4)
        for (int rp = 0; rp < ((DBG_REP_ATT & 4) ? 2 : 1); ++rp)
        conv_unit(C, l, (u >> 5) * SEQ, SEQ, (u & 31) * 64);
#endif
    }
#if !defined(ATT_PART) || (ATT_PART & 8)
    if (first) {
        for (int u = C.vcu; u < 32; u += C.G) {
            const int b = u >> 2, h = u & 3;
            MLA::run(QRAW + (size_t)(TL + b * NCTX) * 768 + h * 192, (const bf16*)((const unsigned char*)KM + (size_t)u * NKEY * 192), (const bf16*)((const unsigned char*)VM + (size_t)u * 128 * NKEY), (bf16*)(CAT + (size_t)(TL + b * NCTX) * DM + h * 128), 4, 256, 0, 0, 0.f, C.lds, C.wave,
                     768, C.in[I_QHN] + l * 192, WSP(float, WS_ROPE), WSP(float, WS_ROPE) + 2048 * 32, 0, false, WSP(float, WS_MQ) + (size_t)(TL + b * NCTX) * 2);
            const int kvh = b * 2 + (h >> 1);
            SWAC::run(SQ + (size_t)32 * SEQ * 64 + (size_t)u * NCTX * 64, SK + (size_t)kvh * NKEY * 64, SV + (size_t)kvh * NKEY * 64, (bf16*)(CAT + (size_t)(TL + b * NCTX) * DM + 768 + h * 64), 4, 256, 0, 0, C.in[I_SINK][l * 4 + h], C.lds, C.wave);
            conv_unit(C, l, TL + (u >> 2) * NCTX, NCTX, (u & 3) * 64);
        }
    }
#endif
}

__device__ __forceinline__ void router_phase(Ctx& C, int l, bool shadow = false) {
    const float* ada = WSP(float, WS_ADA); bf16* HF = WSP(bf16, WS_H); float* RG = shadow ? (float*)(C.ws + WS_END + 4 * MiB) : WSP(float, WS_ROUTEG); int* LISTE = shadow ? (int*)(C.ws + WS_END) : WSP(int, WS_LISTE);
    unsigned* cntg = (unsigned*)(C.ws + WS_CTL) + CW_CNT + (l + (shadow ? 2 : 0)) * 32 * 64;
    float* GSL = shadow ? (float*)(C.ws + WS_END + 16 * MiB) : WSP(float, WS_GSLOT);
    const int ntok = (l == 0) ? NTOK : TL, per = ntok / 256;
    constexpr int TB = 16, HP = 1028;
    LAS float* hfl = (LAS float*)C.lds;
    LAS float* part = (LAS float*)(C.lds + 66048);
    LAS int* lcnt = (LAS int*)(C.lds + 66048 + 16384);
    LAS int* lbase = lcnt + 32;
    LAS int* lent = lcnt + 64;
    const int lane = C.lane, w = C.wave;
    const float* ng = C.in[I_N2G] + l * 1024;
    if (C.tid < 32) lcnt[C.tid] = 0;
    bf16x8 whi[4][2], wlo[4][2];
    { const float* rw = C.in[I_RW] + (size_t)l * 1024 * 32 + (size_t)(128 * w + 8 * (lane >> 4)) * 32 + (lane & 15);
#pragma unroll
      for (int ks = 0; ks < 4; ++ks)
#pragma unroll
        for (int eh = 0; eh < 2; ++eh) { float x[8];
#pragma unroll
          for (int i = 0; i < 8; ++i) x[i] = rw[(ks * 32 + i) * 32 + eh * 16];
          u32x4 h, lo_;
#pragma unroll
          for (int i = 0; i < 4; ++i) { h[i] = cvt_pk_bf16(x[2 * i], x[2 * i + 1]); lo_[i] = cvt_pk_bf16(x[2 * i] - bflo(h[i]), x[2 * i + 1] - bfhi(h[i])); }
          whi[ks][eh] = __builtin_bit_cast(bf16x8, h); wlo[ks][eh] = __builtin_bit_cast(bf16x8, lo_); } }
    const float rbias = C.in[I_RB][l * 32 + (lane & 31)];
    __syncthreads();
    u32x2 vr[2][4];
#define RT_LOAD(BT) do { _Pragma("unroll") for (int s2 = 0; s2 < 2; ++s2) { const int ti_ = (BT) + w + 8 * s2, t_ = C.vcu * per + ti_; \
        const bf16* x_ = WSP(bf16, WS_XS) + (size_t)t_ * DM; \
        _Pragma("unroll") for (int j = 0; j < 4; ++j) vr[s2][j] = (ti_ < per) ? *((const GAS u32x2*)x_ + lane + 64 * j) : (u32x2){0u, 0u}; } } while (0)
    RT_LOAD(0);
    f32x4 ga[4], sf[4]; int rc;
#define RT_MOD(R) do { const float* sh_ = ada + (size_t)(l * 9 + (R)) * 6144 + 3 * 1024; const float* sc_ = sh_ + 1024; \
        _Pragma("unroll") for (int j = 0; j < 4; ++j) { const f32x4 g_ = *((const GAS f32x4*)ng + lane + 64 * j), a_ = *((const GAS f32x4*)sc_ + lane + 64 * j); \
            sf[j] = *((const GAS f32x4*)sh_ + lane + 64 * j); ga[j] = g_ * (a_ + 1.f); } } while (0)
    { const int t0 = C.vcu * per + w; rc = __builtin_amdgcn_readfirstlane((t0 < TL) ? (t0 >> 11) : 8); RT_MOD(rc); }
    for (int bt = 0; bt < per; bt += TB) {
        {
            f32x4 v[2][4];
#pragma unroll
            for (int s2 = 0; s2 < 2; ++s2)
#pragma unroll
                for (int j = 0; j < 4; ++j) { const u32x2 w_ = vr[s2][j]; v[s2][j] = (f32x4){bflo(w_.x), bfhi(w_.x), bflo(w_.y), bfhi(w_.y)}; }
#pragma unroll
            for (int s2 = 0; s2 < 2; ++s2) { const int ti = bt + w + 8 * s2, t = C.vcu * per + ti; const int r = __builtin_amdgcn_readfirstlane((t < TL) ? (t >> 11) : 8);
                if (r != rc) { rc = r; RT_MOD(r); }
                float ss = 0.f;
#pragma unroll
                for (int j = 0; j < 4; ++j) ss += (v[s2][j][0] * v[s2][j][0] + v[s2][j][1] * v[s2][j][1]) + (v[s2][j][2] * v[s2][j][2] + v[s2][j][3] * v[s2][j][3]);
                const float rstd = rsqrtf(wave_sum(ss) * (1.f / DM) + EPS);
#pragma unroll
                for (int j = 0; j < 4; ++j) {
                    const f32x4 h = v[s2][j] * rstd * ga[j] + sf[j]; u32x2 o; o.x = pk2(h[0], h[1]); o.y = pk2(h[2], h[3]);
                    if (ti < per) *((GAS unsigned*)(C.ws + WS_HF8 + (size_t)t * DM) + lane + 64 * j) = pk4_f8(h[0], h[1], h[2], h[3]); (void)o; (void)HF;
                    *((LAS f32x4*)(hfl + (w + 8 * s2) * HP) + lane + 64 * j) = h; } }
        }
        __syncthreads();
        if (bt + TB < per) RT_LOAD(bt + TB);
        {
            f32x4 a0 = {0.f, 0.f, 0.f, 0.f}, a1 = {0.f, 0.f, 0.f, 0.f};
            const LAS float* ap = hfl + (lane & 15) * HP + 128 * w + 8 * (lane >> 4);
#pragma unroll
            for (int ks = 0; ks < 4; ++ks) { const f32x4 x0 = *(const LAS f32x4*)(ap + 32 * ks), x1 = *(const LAS f32x4*)(ap + 32 * ks + 4);
                u32x4 h, lo_;
                h[0] = cvt_pk_bf16(x0[0], x0[1]); h[1] = cvt_pk_bf16(x0[2], x0[3]); h[2] = cvt_pk_bf16(x1[0], x1[1]); h[3] = cvt_pk_bf16(x1[2], x1[3]);
                lo_[0] = cvt_pk_bf16(x0[0] - bflo(h[0]), x0[1] - bfhi(h[0])); lo_[1] = cvt_pk_bf16(x0[2] - bflo(h[1]), x0[3] - bfhi(h[1]));
                lo_[2] = cvt_pk_bf16(x1[0] - bflo(h[2]), x1[1] - bfhi(h[2])); lo_[3] = cvt_pk_bf16(x1[2] - bflo(h[3]), x1[3] - bfhi(h[3]));
                const bf16x8 ah = __builtin_bit_cast(bf16x8, h), al = __builtin_bit_cast(bf16x8, lo_);
                a0 = __builtin_amdgcn_mfma_f32_16x16x32_bf16(al, wlo[ks][0], a0, 0, 0, 0); a1 = __builtin_amdgcn_mfma_f32_16x16x32_bf16(al, wlo[ks][1], a1, 0, 0, 0);
                a0 = __builtin_amdgcn_mfma_f32_16x16x32_bf16(al, whi[ks][0], a0, 0, 0, 0); a1 = __builtin_amdgcn_mfma_f32_16x16x32_bf16(al, whi[ks][1], a1, 0, 0, 0);
                a0 = __builtin_amdgcn_mfma_f32_16x16x32_bf16(ah, wlo[ks][0], a0, 0, 0, 0); a1 = __builtin_amdgcn_mfma_f32_16x16x32_bf16(ah, wlo[ks][1], a1, 0, 0, 0);
                a0 = __builtin_amdgcn_mfma_f32_16x16x32_bf16(ah, whi[ks][0], a0, 0, 0, 0); a1 = __builtin_amdgcn_mfma_f32_16x16x32_bf16(ah, whi[ks][1], a1, 0, 0, 0); }
#pragma unroll
            for (int q = 0; q < 4; ++q) { const int tk = 4 * (lane >> 4) + q; part[(tk * 8 + w) * 32 + (lane & 15)] = a0[q]; part[(tk * 8 + w) * 32 + 16 + (lane & 15)] = a1[q]; }
        }
        __syncthreads();
#pragma unroll
        for (int s2 = 0; s2 < 2; ++s2) {
            const int tl = w + 8 * s2, ti = bt + tl, t = C.vcu * per + ti;
            float val = -INFINITY;
            if (lane < 32) { val = rbias;
#pragma unroll
                for (int p = 0; p < 8; ++p) val += part[(tl * 8 + p) * 32 + lane]; }
            float sv[4]; int se[4];
#pragma unroll
            for (int k = 0; k < 4; ++k) { const float m = wave_max(val); const unsigned long long mk = __ballot(val == m); const int idx = __ffsll((long long)mk) - 1; sv[k] = m; se[k] = idx; if (lane == idx) val = -INFINITY; }
            const float e1 = __expf(sv[1] - sv[0]), e2 = __expf(sv[2] - sv[0]), e3 = __expf(sv[3] - sv[0]); const float inv = 1.f / (1.f + e1 + e2 + e3);
            if (lane < 4 && ti < per) { const int ee = lane == 0 ? se[0] : lane == 1 ? se[1] : lane == 2 ? se[2] : se[3]; const float gg = (lane == 0 ? 1.f : lane == 1 ? e1 : lane == 2 ? e2 : e3) * inv;
                const int lp = __hip_atomic_fetch_add(&lcnt[ee], 1, __ATOMIC_RELAXED, __HIP_MEMORY_SCOPE_WORKGROUP); ((GAS float*)RG)[t * 4 + lane] = gg; lent[(ti * 4 + lane) * 2] = t * 4 + lane; lent[(ti * 4 + lane) * 2 + 1] = (ee << 16) | lp; }
        }
    }
#undef RT_LOAD
#undef RT_MOD
    __syncthreads();
    if (C.tid < 32) lbase[C.tid] = (int)__hip_atomic_fetch_add(cntg + C.tid * 64, (unsigned)lcnt[C.tid], __ATOMIC_RELAXED, __HIP_MEMORY_SCOPE_AGENT);
    __syncthreads();
    for (int i = C.tid; i < per * 4; i += NTHREADS) { const int tk = lent[i * 2], q = lent[i * 2 + 1], ee = q >> 16, lp = q & 0xffff; ((GAS int*)LISTE)[(size_t)ee * NTOK + lbase[ee] + lp] = tk;
        ((GAS float*)GSL)[(size_t)ee * NTOK + lbase[ee] + lp] = __hip_atomic_load(RG + tk, __ATOMIC_RELAXED, __HIP_MEMORY_SCOPE_AGENT); }
    __syncthreads();
}

struct DenseSched {
    const char* A; const char* Bt; int nM, nN, K, G, c;
    __device__ __forceinline__ bool next(int i, pg8::Unit& u) const {
        const int L = i * G + c; if (L >= nM * nN) return false;
        pg8::order_map(L, nM, nN, u.pm, u.pn); u.A = A + (size_t)u.pm * 256 * K * 2; u.B = Bt + (size_t)u.pn * 256 * K * 2; u.par = i & 1; return true; }
    __device__ __forceinline__ unsigned row_off(const pg8::Unit&, int) const { return 0u; }
};
struct PitchSched {
    const char* A; const char* Bt; int nM, nN, K, G, c; unsigned pitch;
    __device__ __forceinline__ bool next(int i, pg8::Unit& u) const {
        const int L = i * G + c; if (L >= nM * nN) return false;
        pg8::order_map(L, nM, nN, u.pm, u.pn); u.A = A; u.B = Bt + (size_t)u.pn * 256 * K * 2; u.par = i & 1; return true; }
    __device__ __forceinline__ unsigned row_off(const pg8::Unit& u, int r) const { return (unsigned)(u.pm * 256 + r) * pitch; }
    __device__ __forceinline__ void list_prefetch(const pg8::Unit&, LAS unsigned char*, int, int) const {}
    __device__ __forceinline__ unsigned row_off_next(const pg8::Unit& u, int r, LAS unsigned char*, int) const { return row_off(u, r); }
};
struct MoeTab { const LAS int* cnt; const LAS int* bstart; const LAS int* blk_e; };
constexpr int LST_OFF = LDSCTL_OFF + 12288;
template <bool G1> struct MoeSched {
    const char* A; const char* W; const int* LISTE; MoeTab T; int NB, nN, G, c; const float* GS;
    __device__ __forceinline__ bool next(int i, pg8::Unit& u) const {
        const int L = i * G + c; if (L >= NB * nN) return false;
        pg8::order_map(L, NB, nN, u.pm, u.pn); const int e = __builtin_amdgcn_readfirstlane(T.blk_e[u.pm]);
        u.A = A; u.B = W + ((size_t)e * nN + u.pn) * 256 * 1024; u.par = i & 1; return true; }
    __device__ __forceinline__ unsigned row_off(const pg8::Unit& u, int r) const {
        if (!G1) return (unsigned)(u.pm * 256 + r) * 1024u;
        const int e = __builtin_amdgcn_readfirstlane(T.blk_e[u.pm]), pos = (u.pm - __builtin_amdgcn_readfirstlane(T.bstart[e])) * 256 + r, cn = __builtin_amdgcn_readfirstlane(T.cnt[e]);
        const int tk = ((const GAS int*)LISTE)[(size_t)e * NTOK + (pos < cn ? pos : 0)]; return (unsigned)(tk >> 2) * (G1 ? 1024u : 2048u); }
    __device__ __forceinline__ void list_prefetch(const pg8::Unit& u, LAS unsigned char* lds, int wid, int par) const {
        if (G1 && wid >= 4) return;
        const int e = __builtin_amdgcn_readfirstlane(T.blk_e[u.pm]), pos0 = (u.pm - __builtin_amdgcn_readfirstlane(T.bstart[e])) * 256, w4 = wid & 3;
        const char* gb = (wid < 4) ? (const char*)(LISTE + (size_t)e * NTOK + pos0 + w4 * 64) : (const char*)(GS + (size_t)e * NTOK + pos0 + w4 * 64);
        const unsigned vo = (unsigned)lane_id_now() * 4u;
        asm volatile("s_mov_b32 m0, %0\n\ts_nop 0\n\tglobal_load_lds_dword %1, %2" :: "s"((unsigned)(uintptr_t)(lds + LST_OFF + (wid < 4 ? 0 : 2048) + par * 1024) + (unsigned)w4 * 256u), "v"(vo), "s"(gb) : "memory"); }
    __device__ __forceinline__ unsigned row_off_next(const pg8::Unit& u, int r, LAS unsigned char* lds, int par) const {
        if (!G1) return row_off(u, r);
        const int e = __builtin_amdgcn_readfirstlane(T.blk_e[u.pm]), pos = (u.pm - __builtin_amdgcn_readfirstlane(T.bstart[e])) * 256 + r, cn = __builtin_amdgcn_readfirstlane(T.cnt[e]);
        const int tk = ((const LAS int*)(lds + LST_OFF + par * 1024))[pos < cn ? r : 0]; return (unsigned)(tk >> 2) * 1024u; }
};
typedef const f32x4 (&AccRef)[2][2][4][2];
struct EpiStoreBf16 { static constexpr bool INIT = false; struct PreT {}; static constexpr bool PERM = true; bf16* O; int ldc;
    __device__ __forceinline__ void operator()(AccRef acc, const pg8::Unit& u, int wr, int wc, int fr, int fq) const {
        const int row0 = u.pm * 256 + wr * 64 + fr, col0 = u.pn * 256 + wc * 32 + 8 * fq;
#pragma unroll
        for (int ai = 0; ai < 2; ++ai)
#pragma unroll
            for (int m = 0; m < 4; ++m) { bf16* rowp = O + (size_t)(row0 + ai * 128 + m * 16) * ldc + col0;
#pragma unroll
                for (int bj = 0; bj < 2; ++bj) { const f32x4 v0 = acc[ai][bj][m][0], v1 = acc[ai][bj][m][1];
                    u32x4 w; w.x = cvt_pk_bf16(v0[0], v0[1]); w.y = cvt_pk_bf16(v0[2], v0[3]); w.z = cvt_pk_bf16(v1[0], v1[1]); w.w = cvt_pk_bf16(v1[2], v1[3]); *(GAS u32x4*)(rowp + bj * 128) = w; } }
    } };
struct EpiKvUp { static constexpr bool INIT = false; struct PreT {}; static constexpr bool PERM = true; bf16* KRAW; bf16* VM;
    __device__ __forceinline__ void operator()(AccRef acc, const pg8::Unit& u, int wr, int wc, int fr, int fq) const {
        const int t0 = u.pm * 256, h = u.pn; const bool isctx = t0 >= TL;
        const int b = isctx ? (t0 - TL) >> 8 : t0 >> 11, key0 = isctx ? 0 : NCTX + (t0 & 2047);
        const int rin = wr * 64 + fr, c0 = wc * 32 + 8 * fq;
        bf16* kr = KRAW + (size_t)t0 * 512 + h * 128 + c0; bf16* vr = VM + ((size_t)(b * 4 + h) * NKEY + key0) * 128 + c0;
#pragma unroll
        for (int ai = 0; ai < 2; ++ai)
#pragma unroll
            for (int m = 0; m < 4; ++m) { const int rr = rin + ai * 128 + m * 16;
                { const f32x4 v0 = acc[ai][0][m][0], v1 = acc[ai][0][m][1]; u32x4 w; w.x = cvt_pk_bf16(v0[0], v0[1]); w.y = cvt_pk_bf16(v0[2], v0[3]); w.z = cvt_pk_bf16(v1[0], v1[1]); w.w = cvt_pk_bf16(v1[2], v1[3]);
                  *(GAS u32x4*)(kr + (size_t)rr * 512) = w; }
                { const f32x4 v0 = acc[ai][1][m][0], v1 = acc[ai][1][m][1]; u32x4 w; w.x = cvt_pk_bf16(v0[0], v0[1]); w.y = cvt_pk_bf16(v0[2], v0[3]); w.z = cvt_pk_bf16(v1[0], v1[1]); w.w = cvt_pk_bf16(v1[2], v1[3]);
                  *(GAS u32x4*)(vr + (size_t)rr * 128) = w; } }
    } };
struct EpiWin { static constexpr bool INIT = false; struct PreT {}; static constexpr bool PERM = true; bf16* P; bf16* CKVN; float* MQ; bf16* SK; bf16* SV; bf16* SQ; bf16* U; const float* gkv; const float* gsk; const float* gsq; const float* ct; const float* st; LAS float* part;
    __device__ __forceinline__ void operator()(AccRef acc, const pg8::Unit& u, int wr, int wc, int fr, int fq) const {
        const int t0 = u.pm * 256, pn = u.pn; const bool isctx = t0 >= TL;
        const int b = isctx ? (t0 - TL) >> 8 : t0 >> 11, key0 = isctx ? 0 : NCTX + (t0 & 2047), pos0 = isctx ? 0 : (t0 & 2047);
        const int rin = wr * 64 + fr, c0 = wc * 32 + 8 * fq;
        if (pn >= 5) {
            bf16* up = U + (size_t)t0 * 256 + (pn - 5) * 128 + c0;
#pragma unroll
            for (int ai = 0; ai < 2; ++ai)
#pragma unroll
                for (int m = 0; m < 4; ++m) { const int rw = rin + ai * 128 + m * 16; float o[8];
#pragma unroll
                    for (int e = 0; e < 8; ++e) o[e] = acc[ai][0][m][e >> 2][e & 3] * sigmoidf_(acc[ai][1][m][e >> 2][e & 3]);
                    u32x4 w; w.x = cvt_pk_bf16(o[0], o[1]); w.y = cvt_pk_bf16(o[2], o[3]); w.z = cvt_pk_bf16(o[4], o[5]); w.w = cvt_pk_bf16(o[6], o[7]);
                    *(GAS u32x4*)(up + (size_t)rw * 256) = w; }
            return;
        }
#pragma unroll
        for (int ai = 0; ai < 2; ++ai)
#pragma unroll
            for (int m = 0; m < 4; ++m)
#pragma unroll
                for (int bj = 0; bj < 2; ++bj) { const f32x4 v0 = acc[ai][bj][m][0], v1 = acc[ai][bj][m][1];
                    float q = ((v0[0] * v0[0] + v0[1] * v0[1]) + (v0[2] * v0[2] + v0[3] * v0[3])) + ((v1[0] * v1[0] + v1[1] * v1[1]) + (v1[2] * v1[2] + v1[3] * v1[3]));
                    q += swz_xor<16>(q); q += xhalf(q);
                    if (fq == 0) part[(rin + ai * 128 + m * 16) * 8 + bj * 4 + wc] = q; }
        asm volatile("s_waitcnt lgkmcnt(0)\n\ts_barrier" ::: "memory");
        if (pn == 0) {
            f32x4 g[2][2];
#pragma unroll
            for (int bj = 0; bj < 2; ++bj)
#pragma unroll
                for (int n = 0; n < 2; ++n) g[bj][n] = *(const GAS f32x4*)(gkv + c0 + bj * 128 + n * 4);
#pragma unroll
            for (int ai = 0; ai < 2; ++ai)
#pragma unroll
                for (int m = 0; m < 4; ++m) { const int rw = rin + ai * 128 + m * 16;
                    const f32x4 pa = *(const LAS f32x4*)(part + rw * 8), pb = *(const LAS f32x4*)(part + rw * 8 + 4);
                    const float rstd = rsqrtf((((pa[0] + pa[1]) + (pa[2] + pa[3])) + ((pb[0] + pb[1]) + (pb[2] + pb[3]))) * (1.f / 256.f) + EPS);
                    bf16* rowp = CKVN + (size_t)(t0 + rw) * 256 + c0;
#pragma unroll
                    for (int bj = 0; bj < 2; ++bj) { const f32x4 v0 = acc[ai][bj][m][0] * rstd * g[bj][0], v1 = acc[ai][bj][m][1] * rstd * g[bj][1];
                        u32x4 w; w.x = cvt_pk_bf16(v0[0], v0[1]); w.y = cvt_pk_bf16(v0[2], v0[3]); w.z = cvt_pk_bf16(v1[0], v1[1]); w.w = cvt_pk_bf16(v1[2], v1[3]); *(GAS u32x4*)(rowp + bj * 128) = w; } }
        } else if (pn <= 2) {
            { const int tid = (wr * 4 + wc) * 64 + fq * 16 + fr;
              if (tid < 256) { const f32x4 pa = *(const LAS f32x4*)(part + tid * 8), pb = *(const LAS f32x4*)(part + tid * 8 + 4);
                  const float s0 = (pa[0] + pa[1]) + (pa[2] + pa[3]), s1 = (pb[0] + pb[1]) + (pb[2] + pb[3]);
                  MQ[(size_t)(t0 + tid) * 2 + (pn - 1)] = (pn == 1) ? s0 + s1 : s0; } }
#pragma unroll
            for (int ai = 0; ai < 2; ++ai)
#pragma unroll
                for (int m = 0; m < 4; ++m) { bf16* rowp = P + (size_t)(t0 + rin + ai * 128 + m * 16) * INP + pn * 256 + c0;
#pragma unroll
                    for (int bj = 0; bj < 2; ++bj) { const f32x4 v0 = acc[ai][bj][m][0], v1 = acc[ai][bj][m][1];
                        u32x4 w; w.x = cvt_pk_bf16(v0[0], v0[1]); w.y = cvt_pk_bf16(v0[2], v0[3]); w.z = cvt_pk_bf16(v1[0], v1[1]); w.w = cvt_pk_bf16(v1[2], v1[3]); *(GAS u32x4*)(rowp + bj * 128) = w; } }
        } else {
            const int hd = wc >> 1, d0 = (wc & 1) * 32 + 8 * fq; const bool x2lane = fq >= 2;
            const float* gp = (pn == 3 ? gsk : gsq) + d0; const f32x4 g0 = *(const GAS f32x4*)gp, g1 = *(const GAS f32x4*)(gp + 4);
            const int tabo = (wc & 1) * 16 + 8 * (fq & 1);
#pragma unroll
            for (int ai = 0; ai < 2; ++ai)
#pragma unroll
                for (int m = 0; m < 4; ++m) { const int rw = rin + ai * 128 + m * 16;
                    const f32x4 pa = *(const LAS f32x4*)(part + rw * 8), pb = *(const LAS f32x4*)(part + rw * 8 + 4);
                    f32x4 cv0, cv1, sv0, sv1;
                    if (!isctx) { const float* cp = ct + (size_t)(pos0 + rw) * 32 + tabo; const float* sp = st + (size_t)(pos0 + rw) * 32 + tabo;
                        cv0 = *(const GAS f32x4*)cp; cv1 = *(const GAS f32x4*)(cp + 4); sv0 = *(const GAS f32x4*)sp; sv1 = *(const GAS f32x4*)(sp + 4); }
                    else { cv0 = cv1 = (f32x4){1.f, 1.f, 1.f, 1.f}; sv0 = sv1 = (f32x4){0.f, 0.f, 0.f, 0.f}; }
#pragma unroll
                    for (int bj = 0; bj < 2; ++bj) {
                        if (pn == 3 && bj == 1) {
                            const f32x4 v0 = acc[ai][1][m][0], v1 = acc[ai][1][m][1]; u32x4 w; w.x = cvt_pk_bf16(v0[0], v0[1]); w.y = cvt_pk_bf16(v0[2], v0[3]); w.z = cvt_pk_bf16(v1[0], v1[1]); w.w = cvt_pk_bf16(v1[2], v1[3]);
                            *(GAS u32x4*)(SV + ((size_t)(b * 2 + hd) * NKEY + key0 + rw) * 64 + d0) = w;
                        } else {
                            const f32x4 pp = bj ? pb : pa; const float ssh = hd ? (pp[2] + pp[3]) : (pp[0] + pp[1]);
                            const float rstd = rsqrtf(ssh * (1.f / 64.f) + EPS);
                            const f32x4 n0 = acc[ai][bj][m][0] * rstd * g0, n1 = acc[ai][bj][m][1] * rstd * g1;
                            float o[8];
#pragma unroll
                            for (int e = 0; e < 8; ++e) { const float nv = e < 4 ? n0[e] : n1[e - 4], pv = xhalf(nv), cc = e < 4 ? cv0[e] : cv1[e - 4], sn = e < 4 ? sv0[e] : sv1[e - 4];
                                o[e] = x2lane ? (pv * sn + nv * cc) : (nv * cc - pv * sn); }
                            u32x4 w; w.x = cvt_pk_bf16(o[0], o[1]); w.y = cvt_pk_bf16(o[2], o[3]); w.z = cvt_pk_bf16(o[4], o[5]); w.w = cvt_pk_bf16(o[6], o[7]);
                            if (pn == 3) *(GAS u32x4*)(SK + ((size_t)(b * 2 + hd) * NKEY + key0 + rw) * 64 + d0) = w;
                            else { const int h4 = bj * 2 + hd; bf16* dst = isctx ? SQ + (size_t)32 * SEQ * 64 + ((size_t)(b * 4 + h4) * NCTX + rw) * 64 : SQ + ((size_t)(b * 4 + h4) * SEQ + pos0 + rw) * 64;
                                *(GAS u32x4*)(dst + d0) = w; } } } }
        }
    } };
struct EpiKvUpN { static constexpr bool INIT = false; struct PreT {}; static constexpr bool PERM = true; bf16* KM; bf16* VM; const bf16* P; const float* khg; const float* ct; const float* st; LAS float* part;
    __device__ __forceinline__ void operator()(AccRef acc, const pg8::Unit& u, int wr, int wc, int fr, int fq) const {
        const int t0 = u.pm * 256, h = u.pn; const bool isctx = t0 >= TL;
        const int b = isctx ? (t0 - TL) >> 8 : t0 >> 11, key0 = isctx ? 0 : NCTX + (t0 & 2047), pos0 = isctx ? 0 : (t0 & 2047);
        const int rin = wr * 64 + fr, c0 = wc * 32 + 8 * fq;
        const int tid = (wr * 4 + wc) * 64 + fq * 16 + fr, rr = tid >> 1, ax = tid & 1;
        const bf16* kp = P + (size_t)(t0 + rr) * INP + NP_KROPE + ax * 32;
        u32x4 kw[4];
#pragma unroll
        for (int i = 0; i < 4; ++i) kw[i] = *(const GAS u32x4*)(kp + i * 8);
#pragma unroll
        for (int ai = 0; ai < 2; ++ai)
#pragma unroll
            for (int m = 0; m < 4; ++m) { const f32x4 v0 = acc[ai][0][m][0], v1 = acc[ai][0][m][1];
                float q = ((v0[0] * v0[0] + v0[1] * v0[1]) + (v0[2] * v0[2] + v0[3] * v0[3])) + ((v1[0] * v1[0] + v1[1] * v1[1]) + (v1[2] * v1[2] + v1[3] * v1[3]));
                q += swz_xor<16>(q); q += xhalf(q);
                if (fq == 0) part[(rin + ai * 128 + m * 16) * 8 + wc] = q; }
        { float ks = 0.f;
#pragma unroll
          for (int i = 0; i < 4; ++i)
#pragma unroll
              for (int w = 0; w < 4; ++w) { const float a = bflo(kw[i][w]), c = bfhi(kw[i][w]); ks += a * a + c * c; }
          part[rr * 8 + 4 + ax] = ks; }
        asm volatile("s_waitcnt lgkmcnt(0)\n\ts_barrier" ::: "memory");
        const f32x4 g0 = *(const GAS f32x4*)(khg + c0), g1 = *(const GAS f32x4*)(khg + c0 + 4);
        unsigned char* kr = (unsigned char*)KM + ((size_t)(b * 4 + h) * NKEY + key0) * 192 + c0; unsigned char* vt = (unsigned char*)VM + (size_t)(b * 4 + h) * 128 * NKEY + key0;
#pragma unroll
        for (int ai = 0; ai < 2; ++ai)
#pragma unroll
            for (int m = 0; m < 4; ++m) { const int rw = rin + ai * 128 + m * 16;
                const f32x4 pa = *(const LAS f32x4*)(part + rw * 8); const f32x2 pb = *(const LAS f32x2*)(part + rw * 8 + 4);
                const float rstd = rsqrtf((((pa[0] + pa[1]) + (pa[2] + pa[3])) + (pb[0] + pb[1])) * (1.f / 192.f) + EPS);
                { const f32x4 v0 = acc[ai][0][m][0] * rstd * g0, v1 = acc[ai][0][m][1] * rstd * g1; u32x2 w; w.x = pk4_f8(v0[0], v0[1], v0[2], v0[3]); w.y = pk4_f8(v1[0], v1[1], v1[2], v1[3]);
                  *(GAS u32x2*)(kr + (size_t)rw * 192) = w; }
                {
                  LAS unsigned char* sc = (LAS unsigned char*)(part + 2048) + (wr * 4 + wc) * 512;
                  const f32x4 v0 = acc[ai][1][m][0], v1 = acc[ai][1][m][1];
#pragma unroll
                  for (int e = 0; e < 8; ++e) { const float vv = e < 4 ? v0[e] : v1[e - 4]; sc[(8 * fq + e) * 16 + fr] = (unsigned char)(__builtin_amdgcn_cvt_pk_fp8_f32(vv, vv, 0, false) & 0xff); }
                  asm volatile("s_waitcnt lgkmcnt(0)" ::: "memory");
                  const int l64 = fq * 16 + fr; const u32x2 w = *(const LAS u32x2*)(sc + (l64 >> 1) * 16 + (l64 & 1) * 8);
                  asm volatile("s_waitcnt lgkmcnt(0)" ::: "memory");
                  *(GAS u32x2*)(vt + (size_t)(wc * 32 + (l64 >> 1)) * NKEY + (wr * 64 + ai * 128 + m * 16) + (l64 & 1) * 8) = w; } }
        {
          const f32x4 pa = *(const LAS f32x4*)(part + rr * 8); const f32x2 pb = *(const LAS f32x2*)(part + rr * 8 + 4);
          const float rstd = rsqrtf((((pa[0] + pa[1]) + (pa[2] + pa[3])) + (pb[0] + pb[1])) * (1.f / 192.f) + EPS);
          const float* gp = khg + 128 + ax * 32; const float* cp = ct + (size_t)(pos0 + rr) * 32 + ax * 16; const float* sp = st + (size_t)(pos0 + rr) * 32 + ax * 16;
          unsigned char* dst = (unsigned char*)KM + ((size_t)(b * 4 + h) * NKEY + key0 + rr) * 192 + 128 + ax * 32;
#pragma unroll
          for (int i = 0; i < 2; ++i) {
              const f32x4 ga0 = *(const GAS f32x4*)(gp + 8 * i), ga1 = *(const GAS f32x4*)(gp + 8 * i + 4), gb0 = *(const GAS f32x4*)(gp + 16 + 8 * i), gb1 = *(const GAS f32x4*)(gp + 16 + 8 * i + 4);
              float x1[8], x2[8];
#pragma unroll
              for (int w = 0; w < 4; ++w) { x1[2 * w] = bflo(kw[i][w]) * rstd * (w < 2 ? ga0[2 * w] : ga1[2 * w - 4]); x1[2 * w + 1] = bfhi(kw[i][w]) * rstd * (w < 2 ? ga0[2 * w + 1] : ga1[2 * w - 3]);
                  x2[2 * w] = bflo(kw[2 + i][w]) * rstd * (w < 2 ? gb0[2 * w] : gb1[2 * w - 4]); x2[2 * w + 1] = bfhi(kw[2 + i][w]) * rstd * (w < 2 ? gb0[2 * w + 1] : gb1[2 * w - 3]); }
              if (!isctx) { const f32x4 c0v = *(const GAS f32x4*)(cp + 8 * i), c1v = *(const GAS f32x4*)(cp + 8 * i + 4), s0v = *(const GAS f32x4*)(sp + 8 * i), s1v = *(const GAS f32x4*)(sp + 8 * i + 4);
#pragma unroll
                  for (int e = 0; e < 8; ++e) { const float cc = e < 4 ? c0v[e] : c1v[e - 4], sn = e < 4 ? s0v[e] : s1v[e - 4]; const float y1 = x1[e], y2 = x2[e]; x1[e] = y1 * cc - y2 * sn; x2[e] = y1 * sn + y2 * cc; } }
              u32x2 w1, w2; w1.x = pk4_f8(x1[0], x1[1], x1[2], x1[3]); w1.y = pk4_f8(x1[4], x1[5], x1[6], x1[7]);
              w2.x = pk4_f8(x2[0], x2[1], x2[2], x2[3]); w2.y = pk4_f8(x2[4], x2[5], x2[6], x2[7]);
              *(GAS u32x2*)(dst + 8 * i) = w1; *(GAS u32x2*)(dst + 16 + 8 * i) = w2; } }
    } };
struct EpiOutRes { static constexpr bool INIT = false; struct PreT {}; struct CarryT {}; static constexpr bool PERM = true; const float* xl_in; const float* xc_in; const bf16* xs_in; bf16* xs_out; const float* ada_l; bool first;
    __device__ __forceinline__ void operator()(AccRef acc, const pg8::Unit& u, int wr, int wc, int fr, int fq) const {
        const int t0 = u.pm * 256; const bool isctx = t0 >= TL; const int r = isctx ? 8 : (t0 >> 11);
        const float* g1 = ada_l + (size_t)r * 6144 + 2 * 1024;
        const int row0 = t0 + wr * 64 + fr, col0 = u.pn * 256 + wc * 32 + 8 * fq;
        f32x4 gv[2][2];
#pragma unroll
        for (int bj = 0; bj < 2; ++bj)
#pragma unroll
            for (int n = 0; n < 2; ++n) gv[bj][n] = *(const GAS f32x4*)(g1 + col0 + bj * 128 + n * 4);
#pragma unroll
        for (int ai = 0; ai < 2; ++ai)
#pragma unroll
            for (int m = 0; m < 4; ++m) { const int row = row0 + ai * 128 + m * 16;
#pragma unroll
                for (int bj = 0; bj < 2; ++bj) { f32x4 x0, x1;
                    if (first) { const float* xp = (isctx ? xc_in + (size_t)(row - TL) * DM : xl_in + (size_t)row * DM) + col0 + bj * 128; x0 = *(const GAS f32x4*)xp; x1 = *(const GAS f32x4*)(xp + 4); }
                    else { const u32x4 w = *(const GAS u32x4*)(xs_in + (size_t)row * DM + col0 + bj * 128); x0 = (f32x4){bflo(w.x), bfhi(w.x), bflo(w.y), bfhi(w.y)}; x1 = (f32x4){bflo(w.z), bfhi(w.z), bflo(w.w), bfhi(w.w)}; }
                    const f32x4 y0 = x0 + gv[bj][0] * acc[ai][bj][m][0], y1 = x1 + gv[bj][1] * acc[ai][bj][m][1];
                    u32x4 o; o.x = cvt_pk_bf16(y0[0], y0[1]); o.y = cvt_pk_bf16(y0[2], y0[3]); o.z = cvt_pk_bf16(y1[0], y1[1]); o.w = cvt_pk_bf16(y1[2], y1[3]);
                    *(GAS u32x4*)(xs_out + (size_t)row * DM + col0 + bj * 128) = o; } }
    } };
struct EpiMoe1 { static constexpr bool INIT = true; static constexpr bool PERM = true; bf16* ACT; const float* b1; MoeTab T;
    struct PreT { f32x4 q[4]; };
    typedef f32x4 (&AccW)[2][2][4][2];
    __device__ __forceinline__ PreT pre(const pg8::Unit& u, int wr, int wc, int fr, int fq) const {
        const int e = __builtin_amdgcn_readfirstlane(T.blk_e[u.pm]); const int j0 = u.pn * 128 + wc * 32 + 8 * fq;
        const float* bp = b1 + (size_t)e * 2048 + 2 * j0; PreT p;
#pragma unroll
        for (int i = 0; i < 4; ++i) p.q[i] = *(const GAS f32x4*)(bp + 4 * i);
        return p; }
    __device__ __forceinline__ void init(AccW acc, const PreT& p) const {
        const f32x4 g0 = {p.q[0][0], p.q[0][2], p.q[1][0], p.q[1][2]}, g1 = {p.q[2][0], p.q[2][2], p.q[3][0], p.q[3][2]};
        const f32x4 l0 = {p.q[0][1], p.q[0][3], p.q[1][1], p.q[1][3]}, l1 = {p.q[2][1], p.q[2][3], p.q[3][1], p.q[3][3]};
#pragma unroll
        for (int a = 0; a < 2; ++a)
#pragma unroll
            for (int m = 0; m < 4; ++m) { acc[a][0][m][0] = g0; acc[a][0][m][1] = g1; acc[a][1][m][0] = l0; acc[a][1][m][1] = l1; } }
    __device__ __forceinline__ void operator()(AccRef acc, const pg8::Unit& u, int wr, int wc, int fr, int fq) const {
        const int j0 = u.pn * 128 + wc * 32 + 8 * fq;
        const int row0 = u.pm * 256 + wr * 64 + fr;
#pragma unroll
        for (int ai = 0; ai < 2; ++ai)
#pragma unroll
            for (int m = 0; m < 4; ++m) { float a[8];
#pragma unroll
                for (int i = 0; i < 8; i += 2) {
                    const f32x2 ug = {acc[ai][0][m][i >> 2][i & 3], acc[ai][0][m][i >> 2][(i & 3) + 1]}, ul = {acc[ai][1][m][i >> 2][i & 3], acc[ai][1][m][i >> 2][(i & 3) + 1]};
                    const f32x2 xg = {fminf(ug[0], 7.f), fminf(ug[1], 7.f)}, xl = {__builtin_amdgcn_fmed3f(ul[0], -7.f, 7.f), __builtin_amdgcn_fmed3f(ul[1], -7.f, 7.f)};
                    const f32x2 tt = xg * (-1.702f * 1.4426950408889634f);
                    const f32x2 dd = (f32x2){__builtin_amdgcn_exp2f(tt[0]), __builtin_amdgcn_exp2f(tt[1])} + 1.f;
                    const f32x2 rr = {__builtin_amdgcn_rcpf(dd[0]), __builtin_amdgcn_rcpf(dd[1])};
                    const f32x2 aa = (xg * rr) * (xl + 1.f); a[i] = aa[0]; a[i + 1] = aa[1]; }
                u32x2 w; w.x = pk4_f8(a[0], a[1], a[2], a[3]); w.y = pk4_f8(a[4], a[5], a[6], a[7]);
                *(GAS u32x2*)((unsigned char*)ACT + (size_t)(row0 + ai * 128 + m * 16) * 1024 + j0) = w; }
    } };
struct EpiMoe2 { static constexpr bool INIT = true; static constexpr bool PERM = true; bf16* YK; const float* b2; const float* RG; const int* LISTE; MoeTab T; LAS unsigned char* lds;
    struct PreT { f32x4 bv[2][2]; };
    typedef f32x4 (&AccW)[2][2][4][2];
    __device__ __forceinline__ PreT pre(const pg8::Unit& u, int wr, int wc, int fr, int fq) const {
        const int e = __builtin_amdgcn_readfirstlane(T.blk_e[u.pm]); const int col0 = u.pn * 256 + wc * 32 + 8 * fq; PreT p;
#pragma unroll
        for (int bj = 0; bj < 2; ++bj)
#pragma unroll
            for (int n = 0; n < 2; ++n) p.bv[bj][n] = *(const GAS f32x4*)(b2 + (size_t)e * 1024 + col0 + bj * 128 + 4 * n);
        return p; }
    __device__ __forceinline__ void init(AccW acc, const PreT& p) const {
#pragma unroll
        for (int a = 0; a < 2; ++a)
#pragma unroll
            for (int bj = 0; bj < 2; ++bj)
#pragma unroll
                for (int m = 0; m < 4; ++m) { acc[a][bj][m][0] = p.bv[bj][0]; acc[a][bj][m][1] = p.bv[bj][1]; } }
    __device__ __forceinline__ void operator()(AccRef acc, const pg8::Unit& u, int wr, int wc, int fr, int fq) const {
        const int e = __builtin_amdgcn_readfirstlane(T.blk_e[u.pm]), pos0 = (u.pm - __builtin_amdgcn_readfirstlane(T.bstart[e])) * 256, cn = __builtin_amdgcn_readfirstlane(T.cnt[e]);
        const int col0 = u.pn * 256 + wc * 32 + 8 * fq;
        int tkv[8]; float gv[8];
        const LAS int* lt = (const LAS int*)(lds + LST_OFF + u.par * 1024); const LAS float* lg = (const LAS float*)(lds + LST_OFF + 2048 + u.par * 1024);
#pragma unroll
        for (int q = 0; q < 8; ++q) { const int rl = wr * 64 + fr + (q >> 2) * 128 + (q & 3) * 16; tkv[q] = (pos0 + rl < cn) ? lt[rl] : -1; gv[q] = lg[rl]; }
#pragma unroll
        for (int ai = 0; ai < 2; ++ai)
#pragma unroll
            for (int m = 0; m < 4; ++m) { const int tk = tkv[ai * 4 + m]; const float g = gv[ai * 4 + m];
                if (tk >= 0) { unsigned char* rowp = (unsigned char*)YK + (size_t)tk * 1024 + col0; const float g32 = g * YK_SCALE;
#pragma unroll
                    for (int bj = 0; bj < 2; ++bj) { const f32x4 v0 = acc[ai][bj][m][0] * g32, v1 = acc[ai][bj][m][1] * g32;
                        u32x2 w; w.x = pk4_f8(v0[0], v0[1], v0[2], v0[3]); w.y = pk4_f8(v1[0], v1[1], v1[2], v1[3]); *(GAS u32x2*)(rowp + bj * 128) = w; } } }
    } };

__device__ __forceinline__ int moe_tables(Ctx& C, int l) {
    LAS int* cnt = (LAS int*)(C.lds + TAB_OFF); LAS int* bstart = cnt + 32; LAS int* blk_e = bstart + 36; LAS int* nbp = blk_e + MAXBLK;
    const unsigned* cntg = (const unsigned*)(C.ws + WS_CTL) + CW_CNT + l * 32 * 64;
    __syncthreads();
    if (C.tid < 32) cnt[C.tid] = (int)__hip_atomic_load(cntg + C.tid * 64, __ATOMIC_RELAXED, __HIP_MEMORY_SCOPE_AGENT);
    __syncthreads();
    if (C.tid < 32) { const int e = C.tid; int st = 0, tot = 0;
#pragma nounroll
        for (int j = 0; j < 32; ++j) { const int nb = (cnt[j] + 255) >> 8; st += (j < e) ? nb : 0; tot += nb; }
        bstart[e] = st; if (e == 0) { bstart[32] = tot; nbp[0] = tot; }
        const int nbe = (cnt[e] + 255) >> 8;
#pragma clang loop vectorize(disable) unroll(disable)
        for (int b = 0; b < nbe; ++b) blk_e[st + b] = e; }
    __syncthreads();
    return __builtin_amdgcn_readfirstlane(nbp[0]);
}

__device__ __forceinline__ void fresh_lane(Ctx& C) { const int ln = lane_id_now(); C.lane = ln; C.tid = C.wave * 64 + ln; C.gw = C.vcu * NWAVES + C.wave; }
__device__ __forceinline__ void fresh_ids(Ctx& C, unsigned char* ws) {
    asm volatile("" : "+s"(ws)); C.ws = ws;
    KArgs kp = (KArgs)__builtin_amdgcn_kernarg_segment_ptr(); asm volatile("" : "+s"(kp)); C.in = kp;
}
constexpr int PH_PER_LAYER = 8, N_PHASES = 1 + NLAYER * PH_PER_LAYER + 1;
__global__ void __launch_bounds__(NTHREADS, 2) mk_fwd(Args args) {
    extern __shared__ __attribute__((aligned(16))) unsigned char lds_raw[];
    Ctx C;
    C.lds = (LAS unsigned char*)lds_raw; C.ldsg = (char*)lds_raw;
    C.wave = __builtin_amdgcn_readfirstlane(threadIdx.x >> 6); C.lane = lane_id_now(); C.tid = C.wave * 64 + C.lane;
    C.G = gridDim.x; { const int bx = blockIdx.x; C.vcu = (C.G % 8 == 0) ? (bx % 8) * (C.G / 8) + bx / 8 : bx; }
    C.gw = C.vcu * NWAVES + C.wave; C.NGW = C.G * NWAVES;
    C.ws = args.ws; C.in = (KArgs)__builtin_amdgcn_kernarg_segment_ptr(); C.out = args.out;
    volatile LAS unsigned* MISC = (volatile LAS unsigned*)(C.lds + MISC_OFF);
    for (int u = C.tid; u < (LDS_BYTES - LDSCTL_OFF) / 4; u += NTHREADS) ((LAS unsigned*)(C.lds + LDSCTL_OFF))[u] = 0u;
    __syncthreads();
    const int lo = args.ph_lo, hi = args.ph_hi;
    const bool multi = (hi - lo) > 1;
    XcdBarrier bar; bar.bar = (unsigned*)(C.ws + WS_CTL) + CW_BAR; bar.x = 0; bar.st = nullptr;
    if (multi) bar = xcd_barrier_post((unsigned*)(C.ws + WS_CTL) + CW_BAR, MISC + 8, C.tid);
#ifdef PH_ONLY
#define PHK(kind) ((kind) == PH_ONLY)
#else
#define PHK(kind) true
#endif
    for (int ph = lo; ph < hi; ++ph) {
        fresh_ids(C, args.ws);
        int kind, l;
        if (ph == 0) { kind = 0; l = 0; } else if (ph == N_PHASES - 1) { kind = 11; l = NLAYER - 1; } else { l = (ph - 1) / PH_PER_LAYER; const int k = (ph - 1) % PH_PER_LAYER; kind = k < 2 ? k + 1 : k == 2 ? 4 : k + 3; }
        unsigned char* wb = C.ws + WS_W + (size_t)l * WB_LAYER;
        const bool last = (l == NLAYER - 1);
        const float* ada_l = WSP(float, WS_ADA) + (size_t)l * 9 * 6144;
#ifndef DBG_REPEAT_KIND
#define DBG_REPEAT_KIND -1
#endif
        const int reps = (kind == DBG_REPEAT_KIND && (l == 0 || (kind != 1 && kind != 7))) ? 2 : 1;
        for (int rep = 0; rep < reps; ++rep) {
        if (rep > 0) { fresh_lane(C); xcd_barrier(bar, C.tid); }
        switch (kind) {
        case 0: if (PHK(0)) { fresh_lane(C); p0_prologue(C); } break;
        case 1: if (PHK(1)) { fresh_lane(C); norm1_phase(C, l); if (l == 1) { const int NB0 = moe_tables(C, 0); const int done = cvt_n6() + cvt_n7() + cvt_idle(NB0 * 8, C.G) * NWAVES * CVT_Q9 + cvt_idle(NB0 * 4, C.G) * NWAVES * CVT_Q10;
            fresh_lane(C); for (int it = done + C.gw; it < CVT_ITEMS; it += C.NGW) cvt_layer_item(C, 1, it); } } break;
        case 2: if (PHK(2)) { PitchSched S{(const char*)WSP(bf16, WS_H), (const char*)(wb + WB_IN), NTOK / 256, INP / 256, 512  , C.G, (int)blockIdx.x, 1024u};
            EpiWin E{WSP(bf16, WS_P), WSP(bf16, WS_CKVN), WSP(float, WS_MQ), WSP(bf16, WS_SK), WSP(bf16, WS_SV), WSP(bf16, WS_SQ), WSP(bf16, WS_U), C.in[I_KVNORM] + l * 256, C.in[I_SKN] + l * 64, C.in[I_SQN] + l * 64,
                     WSP(float, WS_ROPE), WSP(float, WS_ROPE) + 2048 * 32, (LAS float*)(C.lds + LDSCTL_OFF + 4096)};
            pg8::gemm_phase<EpiWin, PitchSched, true, true>(C.lds, 1024, S, E, C.wave); } break;
        case 4: if (PHK(4)) {
            { DenseSched S{(const char*)WSP(bf16, WS_CKVN), (const char*)(wb + WB_UKV), NTOK / 256, 4, 256, C.G, (int)blockIdx.x};
              EpiKvUpN E{WSP(bf16, WS_KMLA), WSP(bf16, WS_VMLA), WSP(bf16, WS_P), C.in[I_KHN] + l * 192, WSP(float, WS_ROPE), WSP(float, WS_ROPE) + 2048 * 32, (LAS float*)(C.lds + LDSCTL_OFF + 4096)};
              pg8::gemm_phase<EpiKvUpN, DenseSched, false>(C.lds, 256, S, E, C.wave); }
            { PitchSched S{(const char*)(WSP(bf16, WS_P) + NP_CQ), (const char*)(wb + WB_UQ), (last ? TL : NTOK) / 256, 3, 384, C.G, (int)((blockIdx.x + C.G - 32) % C.G), (unsigned)(INP * 2)};
              EpiStoreBf16 E{WSP(bf16, WS_QRAW), 768}; pg8::gemm_phase<EpiStoreBf16, PitchSched, true>(C.lds, 384, S, E, C.wave); }
        } break;
        case 6: if (PHK(6)) { const bool cv6 = (l == 0 && C.vcu >= 32);
            if (cv6 && (C.vcu & 1)) { fresh_lane(C); cvt_static(C, 0, (C.vcu - 32) * NWAVES + C.wave, 224 * NWAVES, CVT_Q6); __syncthreads(); }
            fresh_lane(C); attn_phase(C, l);
            if (cv6 && !(C.vcu & 1)) { fresh_lane(C); cvt_static(C, 0, (C.vcu - 32) * NWAVES + C.wave, 224 * NWAVES, CVT_Q6); } } break;
        case 7: if (PHK(7)) { PitchSched S{(const char*)WSP(bf16, WS_CAT), (const char*)(wb + WB_OUT), (last ? TL : NTOK) / 256, 4, 512, C.G, (int)blockIdx.x, 1024u};
            EpiOutRes E{C.in[I_X], C.in[I_CTX], WSP(bf16, WS_XS), WSP(bf16, WS_XS), ada_l, l == 0};
            pg8::gemm_phase<EpiOutRes, PitchSched, true, true>(C.lds, 1024, S, E, C.wave);
            if (l == 0 && (int)blockIdx.x >= 32) { fresh_lane(C); cvt_static(C, cvt_n6(), ((int)blockIdx.x - 32) * NWAVES + C.wave, 224 * NWAVES, CVT_Q7); } } break;
        case 8: if (PHK(8)) { fresh_lane(C); router_phase(C, l, reps > 1 && rep == 0); } break;
        case 9: if (PHK(9)) { fresh_lane(C); const int NB = moe_tables(C, l); MoeTab T{(const LAS int*)(C.lds + TAB_OFF), (const LAS int*)(C.lds + TAB_OFF) + 32, (const LAS int*)(C.lds + TAB_OFF) + 68};
            MoeSched<true> S{(const char*)(C.ws + WS_HF8), (const char*)(wb + WB_W1), WSP(int, WS_LISTE), T, NB, 8, C.G, (int)blockIdx.x, WSP(float, WS_GSLOT)};
            EpiMoe1 E{WSP(bf16, WS_ACT), C.in[I_B1] + (size_t)l * NE * 2048, T}; pg8::gemm_phase<EpiMoe1, MoeSched<true>, true, true>(C.lds, 1024, S, E, C.wave);
            { const int rem = (NB * 8) % C.G; if (l == 0 && rem && (int)blockIdx.x >= rem) { fresh_lane(C); cvt_static(C, cvt_n6() + cvt_n7(), ((int)blockIdx.x - rem) * NWAVES + C.wave, (C.G - rem) * NWAVES, CVT_Q9); } } } break;
        case 10: if (PHK(10)) { fresh_lane(C); const int NB = (MK_N_LAUNCHES > 1) ? moe_tables(C, l) : __builtin_amdgcn_readfirstlane(((const LAS int*)(C.lds + TAB_OFF))[68 + MAXBLK]);     MoeTab T{(const LAS int*)(C.lds + TAB_OFF), (const LAS int*)(C.lds + TAB_OFF) + 32, (const LAS int*)(C.lds + TAB_OFF) + 68};
            MoeSched<false> S{(const char*)WSP(bf16, WS_ACT), (const char*)(wb + WB_W2), WSP(int, WS_LISTE), T, NB, 4, C.G, (int)blockIdx.x, WSP(float, WS_GSLOT)};
            EpiMoe2 E{WSP(bf16, WS_YK), C.in[I_B2] + (size_t)l * NE * 1024, WSP(float, WS_ROUTEG), WSP(int, WS_LISTE), T, C.lds}; pg8::gemm_phase<EpiMoe2, MoeSched<false>, true, true>(C.lds, 1024, S, E, C.wave);
            { const int rem = (NB * 4) % C.G; if (l == 0 && rem && (int)blockIdx.x >= rem) { fresh_lane(C); cvt_static(C, cvt_n6() + cvt_n7() + cvt_idle(NB * 8, C.G) * NWAVES * CVT_Q9, ((int)blockIdx.x - rem) * NWAVES + C.wave, (C.G - rem) * NWAVES, CVT_Q10); } } } break;
        default: if (PHK(11)) { fresh_lane(C); final_phase(C); } break;
        }
        }
        if (ph + 1 < hi) { fresh_lane(C); xcd_barrier(bar, C.tid); }
    }
#undef PHK
}

extern "C" void kernel_launch(void* const* d_in, const int* in_sizes, int n_in, void* d_out, int out_size, void* d_ws, size_t ws_size, hipStream_t stream) {
    static int grid = 0;
    if (grid == 0) {
        if (n_in != 29 || in_sizes[0] != TL * DM || out_size != TL * DM || ws_size < WS_END) { fprintf(stderr, "kernel_launch: unexpected shapes (n_in %d, in0 %d, out %d, ws %zu < %zu?)\n", n_in, n_in > 0 ? in_sizes[0] : -1, out_size, ws_size, (size_t)WS_END); grid = -1; return; }
        int dev = 0, cus = 0, per_cu = 0;
        if (hipGetDevice(&dev) != hipSuccess || hipDeviceGetAttribute(&cus, hipDeviceAttributeMultiprocessorCount, dev) != hipSuccess) { grid = -1; return; }
        if (hipFuncSetAttribute((const void*)mk_fwd, hipFuncAttributeMaxDynamicSharedMemorySize, LDS_BYTES) != hipSuccess) { fprintf(stderr, "kernel_launch: hipFuncSetAttribute failed\n"); grid = -1; return; }
        if (hipOccupancyMaxActiveBlocksPerMultiprocessor(&per_cu, (const void*)mk_fwd, NTHREADS, LDS_BYTES) != hipSuccess || per_cu < 1) fprintf(stderr, "kernel_launch: occupancy query reports %d\n", per_cu);
        (void)hipGetLastError();
        grid = cus;
        if (grid != 256) fprintf(stderr, "kernel_launch: %d CUs; this kernel is built for 256\n", grid);
    }
    if (grid < 0) return;
    if (hipMemsetAsync((char*)d_ws + WS_CTL, 0, CTL_BYTES, stream) != hipSuccess) return;
    Args a{};
    for (int i = 0; i < 29; ++i) a.in[i] = (const float*)d_in[i];
    a.out = (float*)d_out; a.ws = (unsigned char*)d_ws;
#if MK_N_LAUNCHES == 1
    a.ph_lo = 0; a.ph_hi = N_PHASES;
    hipLaunchKernelGGL(mk_fwd, dim3(grid), dim3(NTHREADS), LDS_BYTES, stream, a);
#else
    for (int p = 0; p < N_PHASES; ++p) { a.ph_lo = p; a.ph_hi = p + 1; hipLaunchKernelGGL(mk_fwd, dim3(grid), dim3(NTHREADS), LDS_BYTES, stream, a); }
#endif
    const hipError_t le = hipPeekAtLastError();
    if (le != hipSuccess) fprintf(stderr, "kernel_launch: launch failed: %s\n", hipGetErrorName(le));
}
```
